# Optimizing an MI355X kernel written in HIP

```python
import math
import jax
import jax.numpy as jnp
from jax import lax
import numpy as np


D_MODEL = 1024
BATCH = 8
SEQ = 2048
DEPTH = 4

GRID_W = 64
CTX_LEN = 256
EPS = 1e-6
CHUNK = 128
ATTN_BLOCK = 128
D_FF = 4 * D_MODEL
CONV_K = 5

MLA_HEADS = 8
MLA_NOPE = 64
MLA_ROPE = 32
MLA_V = 64
Q_LORA = 256
KV_LORA = 256
ROPE_THETA = 10000.0
MLA_SCALE = (MLA_NOPE + MLA_ROPE) ** -0.5

SSM_HEADS = 8
SSM_HEADDIM = 64
SSM_DINNER = SSM_HEADS * SSM_HEADDIM
SSM_GROUPS = 2
SSM_STATE = 128

MLSTM_HEADS = 8
MLSTM_DQK = 64
MLSTM_DV = 128
MLSTM_QK = MLSTM_HEADS * MLSTM_DQK
MLSTM_VW = MLSTM_HEADS * MLSTM_DV

EVEN_IN = Q_LORA + KV_LORA + MLA_ROPE + SSM_DINNER + SSM_DINNER + 2 * SSM_GROUPS * SSM_STATE + 2 * SSM_HEADS
ODD_IN = 2 * MLSTM_QK + 2 * MLSTM_VW + 4 * MLSTM_HEADS

kernel_name = 'hybrid_mla_ssd_mlstm_prefix_dit'


def split_cols(u, sizes):
    offs = np.cumsum(sizes)[:-1].tolist()
    return jnp.split(u, offs, axis=-1)


def rmsnorm(x, w):
    xf = x.astype(jnp.float32)
    y = xf * lax.rsqrt(jnp.mean(xf * xf, axis=-1, keepdims=True) + EPS)
    return (y * w).astype(x.dtype)


def modulate(h, shift, scale):
    return h * (1.0 + scale) + shift


def sqrelu_mlp(h, w1, w2):
    return (jnp.square(jax.nn.relu(h @ w1)) @ w2).astype(h.dtype)


def dwconv_silu(x, w, b):
    ch = x.shape[-1]
    y = lax.conv_general_dilated(x, w[:, None, :].astype(x.dtype), window_strides=(1,),
                                 padding=[(CONV_K // 2, CONV_K // 2)],
                                 dimension_numbers=('NWC', 'WIO', 'NWC'), feature_group_count=ch)
    return jax.nn.silu(y + b)


def rope2d_tables(length):
    n_rows = length // GRID_W
    row = jnp.repeat(jnp.arange(n_rows), GRID_W).astype(jnp.float32)
    col = jnp.tile(jnp.arange(GRID_W), n_rows).astype(jnp.float32)
    half = MLA_ROPE // 2
    inv = 1.0 / (ROPE_THETA ** (jnp.arange(0, half, 2, dtype=jnp.float32) / half))
    ar = row[:, None] * inv
    ac = col[:, None] * inv
    return tuple(t[None, :, None, :] for t in (jnp.cos(ar), jnp.sin(ar), jnp.cos(ac), jnp.sin(ac)))


def rope_rotate(x, cos, sin):
    x1, x2 = jnp.split(x, 2, axis=-1)
    return jnp.concatenate([x1 * cos - x2 * sin, x2 * cos + x1 * sin], axis=-1)


def rope2d(x, tabs):
    cr, sr, cc, sc = tabs
    xr, xc = jnp.split(x, 2, axis=-1)
    return jnp.concatenate([rope_rotate(xr, cr, sr), rope_rotate(xc, cc, sc)], axis=-1).astype(x.dtype)


def attend(q, k, v):
    s = jnp.einsum('bqhd,bkhd->bhqk', q, k).astype(jnp.float32) * MLA_SCALE
    p = jax.nn.softmax(s, axis=-1).astype(v.dtype)
    return jnp.einsum('bhqk,bkhd->bqhd', p, v)


def ssd_scan(x, dt, a_coef, bm, cm, h0):
    bsz, length, nh, hp = x.shape
    ng, ns = bm.shape[-2:]
    nr = nh // ng
    nc = length // CHUNK
    xf = x.astype(jnp.float32).reshape(bsz, nc, CHUNK, ng, nr, hp)
    dtc = dt.reshape(bsz, nc, CHUNK, ng, nr)
    bc = bm.astype(jnp.float32).reshape(bsz, nc, CHUNK, ng, ns)
    cc = cm.astype(jnp.float32).reshape(bsz, nc, CHUNK, ng, ns)
    acum = jnp.cumsum(dtc * a_coef.reshape(ng, nr), axis=2)
    causal = jnp.tril(jnp.ones((CHUNK, CHUNK), bool))
    seg = acum[:, :, :, None] - acum[:, :, None, :]
    decay = jnp.exp(jnp.where(causal[:, :, None, None], seg, -jnp.inf))
    cb = jnp.einsum('bctgn,bcsgn->bctsg', cc, bc)
    w = cb[..., None] * decay * dtc[:, :, None]
    y = jnp.einsum('bctsgr,bcsgrp->bctgrp', w, xf)
    to_end = jnp.exp(acum[:, :, -1:] - acum) * dtc
    s_chunk = jnp.einsum('bcsgr,bcsgrp,bcsgn->bcgrpn', to_end, xf, bc)
    chunk_decay = jnp.exp(acum[:, :, -1])

    def step(h, inp):
        s_c, d_c = inp
        return d_c[..., None, None] * h + s_c, h

    h_last, h_in = lax.scan(step, h0.reshape(bsz, ng, nr, hp, ns),
                            (jnp.moveaxis(s_chunk, 1, 0), jnp.moveaxis(chunk_decay, 1, 0)))
    h_in = jnp.moveaxis(h_in, 0, 1)
    y = y + jnp.einsum('bctgn,bcgrpn->bctgrp', cc, h_in) * jnp.exp(acum)[..., None]
    return y.reshape(bsz, length, nh, hp), h_last.reshape(bsz, nh, hp, ns)


def mlstm_scan(q, k, v, i_pre, f_pre, state, with_output):
    bsz, length, nh, dk = q.shape
    dv = v.shape[-1]
    nc = length // CHUNK
    qc = q.astype(jnp.float32).reshape(bsz, nc, CHUNK, nh, dk)
    kc = k.astype(jnp.float32).reshape(bsz, nc, CHUNK, nh, dk)
    vc = v.astype(jnp.float32).reshape(bsz, nc, CHUNK, nh, dv)
    ic = i_pre.reshape(bsz, nc, CHUNK, nh)
    b = jnp.cumsum(jax.nn.log_sigmoid(f_pre).reshape(bsz, nc, CHUNK, nh), axis=2)
    b_last = b[:, :, -1]
    w_end = b_last[:, :, None] - b + ic

    def step(carry, inp):
        c_st, n_st, m_st = carry
        k_c, v_c, w_c, bl_c = inp
        m_new = jnp.maximum(bl_c + m_st, jnp.max(w_c, axis=1))
        keep = jnp.exp(bl_c + m_st - m_new)
        wt = jnp.exp(w_c - m_new[:, None])
        c_new = keep[..., None, None] * c_st + jnp.einsum('bsh,bshv,bshk->bhvk', wt, v_c, k_c)
        n_new = keep[..., None] * n_st + jnp.einsum('bsh,bshk->bhk', wt, k_c)
        return (c_new, n_new, m_new), (c_st, n_st, m_st)

    xs = (jnp.moveaxis(kc, 1, 0), jnp.moveaxis(vc, 1, 0), jnp.moveaxis(w_end, 1, 0), jnp.moveaxis(b_last, 1, 0))
    final, (c_in, n_in, m_in) = lax.scan(step, state, xs)
    if not with_output:
        return None, final
    c_in = jnp.moveaxis(c_in, 0, 1)
    n_in = jnp.moveaxis(n_in, 0, 1)
    m_in = jnp.moveaxis(m_in, 0, 1)
    causal = jnp.tril(jnp.ones((CHUNK, CHUNK), bool))
    logd = b[:, :, :, None] - b[:, :, None, :] + ic[:, :, None, :]
    logd = jnp.where(causal[:, :, None], logd, -jnp.inf)
    g = b + m_in[:, :, None]
    m_t = jnp.maximum(g, jnp.max(logd, axis=3))
    dmat = jnp.exp(logd - m_t[:, :, :, None])
    keep = jnp.exp(g - m_t)
    a = jnp.einsum('bcthd,bcshd->bctsh', qc, kc) * dmat
    num = jnp.einsum('bctsh,bcshv->bcthv', a, vc) + keep[..., None] * jnp.einsum('bcthk,bchvk->bcthv', qc, c_in)
    den = jnp.sum(a, axis=3) + keep * jnp.einsum('bcthk,bchk->bcth', qc, n_in)
    h = num / jnp.maximum(jnp.abs(den), jnp.exp(-m_t))[..., None]
    return h.reshape(bsz, length, nh, dv), final


def gated_rmsnorm(y, z, w):
    b_, l_ = z.shape[:2]
    g = y.reshape(b_, l_, SSM_GROUPS, -1) * jax.nn.silu(z.astype(jnp.float32)).reshape(b_, l_, SSM_GROUPS, -1)
    g = g * lax.rsqrt(jnp.mean(g * g, axis=-1, keepdims=True) + EPS)
    return g.reshape(b_, l_, SSM_DINNER) * w


def mla_ssd_mixer(h_ctx, h_lat, rope, w_in, q_norm_w, w_uq, kv_norm_w, w_ukv, conv_w, conv_b,
                  dt_bias, a_log, d_skip, ssm_norm_w, w_out, need_ctx):
    sizes = [Q_LORA, KV_LORA, MLA_ROPE, SSM_DINNER, SSM_DINNER + 2 * SSM_GROUPS * SSM_STATE, 2 * SSM_HEADS]
    parts_c = split_cols(h_ctx @ w_in, sizes)
    parts_l = split_cols(h_lat @ w_in, sizes)

    def mla_qkv(cq, ckv, k_rope, tabs):
        b_, l_ = cq.shape[:2]
        q = (rmsnorm(cq, q_norm_w) @ w_uq).reshape(b_, l_, MLA_HEADS, MLA_NOPE + MLA_ROPE)
        kv = (rmsnorm(ckv, kv_norm_w) @ w_ukv).reshape(b_, l_, MLA_HEADS, MLA_NOPE + MLA_V)
        q_nope, q_rope = jnp.split(q, [MLA_NOPE], axis=-1)
        k_nope, v = jnp.split(kv, [MLA_NOPE], axis=-1)
        k_rope = k_rope[:, :, None, :]
        if tabs is not None:
            q_rope = rope2d(q_rope, tabs)
            k_rope = rope2d(k_rope, tabs)
        q = jnp.concatenate([q_nope, q_rope], axis=-1)
        k = jnp.concatenate([k_nope, jnp.broadcast_to(k_rope, k_nope.shape[:3] + (MLA_ROPE,)).astype(k_nope.dtype)], axis=-1)
        return q, k, v

    q_c, k_c, v_c = mla_qkv(parts_c[0], parts_c[1], parts_c[2], None)
    q_l, k_l, v_l = mla_qkv(parts_l[0], parts_l[1], parts_l[2], rope)
    k_all = jnp.concatenate([k_l, k_c], axis=1)
    v_all = jnp.concatenate([v_l, v_c], axis=1)
    b_, l_ = h_lat.shape[:2]
    nb = l_ // ATTN_BLOCK
    q_blocks = jnp.moveaxis(q_l.reshape(b_, nb, ATTN_BLOCK, MLA_HEADS, MLA_NOPE + MLA_ROPE), 1, 0)
    o_l = lax.map(lambda qb: attend(qb, k_all, v_all), q_blocks)
    o_l = jnp.moveaxis(o_l, 0, 1).reshape(b_, l_, MLA_HEADS * MLA_V)

    def ssd_in(parts):
        z, xbc, dtr = parts[3], parts[4], parts[5]
        bb, ll = z.shape[:2]
        xbc = dwconv_silu(xbc, conv_w, conv_b)
        xs, bm, cm = split_cols(xbc, [SSM_DINNER, SSM_GROUPS * SSM_STATE, SSM_GROUPS * SSM_STATE])
        dt = jax.nn.softplus(dtr.astype(jnp.float32).reshape(bb, ll, 2, SSM_HEADS) + dt_bias)
        return (z, xs.reshape(bb, ll, SSM_HEADS, SSM_HEADDIM), bm.reshape(bb, ll, SSM_GROUPS, SSM_STATE),
                cm.reshape(bb, ll, SSM_GROUPS, SSM_STATE), dt)

    z_c, x_c, b_c, c_c, dt_c = ssd_in(parts_c)
    z_l, x_l, b_l, c_l, dt_l = ssd_in(parts_l)
    a_coef = -jnp.exp(a_log.astype(jnp.float32))
    h0 = jnp.zeros((b_, SSM_HEADS, SSM_HEADDIM, SSM_STATE), jnp.float32)
    y_c = d_skip[:, None] * x_c.astype(jnp.float32)
    y_l = d_skip[:, None] * x_l.astype(jnp.float32)
    for d in range(2):
        fl = (lambda t: jnp.flip(t, axis=1)) if d else (lambda t: t)
        yc_d, h_d = ssd_scan(fl(x_c), fl(dt_c[:, :, d]), a_coef[d], fl(b_c), fl(c_c), h0)
        yl_d, _ = ssd_scan(fl(x_l), fl(dt_l[:, :, d]), a_coef[d], fl(b_l), fl(c_l), h_d)
        y_c = y_c + fl(yc_d)
        y_l = y_l + fl(yl_d)
    s_l = gated_rmsnorm(y_l, z_l, ssm_norm_w).astype(o_l.dtype)
    out_l = (jnp.concatenate([o_l, s_l], axis=-1) @ w_out).astype(h_lat.dtype)
    if not need_ctx:
        return None, out_l
    o_c = attend(q_c, k_c, v_c).reshape(b_, q_c.shape[1], MLA_HEADS * MLA_V)
    s_c = gated_rmsnorm(y_c, z_c, ssm_norm_w).astype(o_c.dtype)
    out_c = (jnp.concatenate([o_c, s_c], axis=-1) @ w_out).astype(h_ctx.dtype)
    return out_c, out_l


def mlstm_mixer(h_ctx, h_lat, w_in, conv_w, conv_b, i_bias, f_bias, head_norm_w, w_out, need_ctx):
    def project(h):
        bb, ll = h.shape[:2]
        qk, v, o, ig, fg = split_cols(h @ w_in, [2 * MLSTM_QK, MLSTM_VW, MLSTM_VW, 2 * MLSTM_HEADS, 2 * MLSTM_HEADS])
        q, k = jnp.split(dwconv_silu(qk, conv_w, conv_b), 2, axis=-1)
        q = q.reshape(bb, ll, MLSTM_HEADS, MLSTM_DQK)
        k = k.reshape(bb, ll, MLSTM_HEADS, MLSTM_DQK) * (MLSTM_DQK ** -0.5)
        v = v.reshape(bb, ll, MLSTM_HEADS, MLSTM_DV)
        ig = ig.astype(jnp.float32).reshape(bb, ll, 2, MLSTM_HEADS) + i_bias
        fg = fg.astype(jnp.float32).reshape(bb, ll, 2, MLSTM_HEADS) + f_bias
        return q, k, v, o, ig, fg

    q_c, k_c, v_c, o_c, i_c, f_c = project(h_ctx)
    q_l, k_l, v_l, o_l, i_l, f_l = project(h_lat)
    b_ = h_lat.shape[0]
    zero = (jnp.zeros((b_, MLSTM_HEADS, MLSTM_DV, MLSTM_DQK), jnp.float32),
            jnp.zeros((b_, MLSTM_HEADS, MLSTM_DQK), jnp.float32),
            jnp.zeros((b_, MLSTM_HEADS), jnp.float32))
    lat_h = []
    ctx_h = []
    for d in range(2):
        fl = (lambda t: jnp.flip(t, axis=1)) if d else (lambda t: t)
        hc_d, st = mlstm_scan(fl(q_c), fl(k_c), fl(v_c), fl(i_c[:, :, d]), fl(f_c[:, :, d]), zero, need_ctx)
        hl_d, _ = mlstm_scan(fl(q_l), fl(k_l), fl(v_l), fl(i_l[:, :, d]), fl(f_l[:, :, d]), st, True)
        lat_h.append(fl(hl_d))
        if need_ctx:
            ctx_h.append(fl(hc_d))

    def finish(ht, o, like):
        bb, ll = ht.shape[:2]
        hn = ht * lax.rsqrt(jnp.mean(ht * ht, axis=-1, keepdims=True) + EPS)
        hn = hn.reshape(bb, ll, MLSTM_VW) * head_norm_w
        return ((jax.nn.sigmoid(o.astype(jnp.float32)) * hn) @ w_out).astype(like.dtype)

    out_l = finish(lat_h[0] + lat_h[1], o_l, h_lat)
    if not need_ctx:
        return None, out_l
    return finish(ctx_h[0] + ctx_h[1], o_c, h_ctx), out_l


def setup_inputs(seed: int = 0) -> dict:
    key = jax.random.key(seed)
    ks = iter(jax.random.split(key, 48))
    f32 = jnp.float32
    ne = (DEPTH + 1) // 2
    no = DEPTH // 2

    def nrm(shape, scale):
        return jax.random.normal(next(ks), shape, f32) * scale

    def gain(shape):
        return 1.0 + nrm(shape, 0.02)

    x = nrm((BATCH, SEQ, D_MODEL), 1.0)
    c = nrm((BATCH, D_MODEL), 1.0)
    ctx = nrm((BATCH, CTX_LEN, D_MODEL), 1.0)
    c_ctx = nrm((D_MODEL,), 1.0)
    ada_w = nrm((DEPTH, D_MODEL, 6 * D_MODEL), 0.5 * D_MODEL ** -0.5)
    ada_b = nrm((DEPTH, 6 * D_MODEL), 0.02)
    norm_mix_w = gain((DEPTH, D_MODEL))
    norm_mlp_w = gain((DEPTH, D_MODEL))
    mlp_w1 = nrm((DEPTH, D_MODEL, D_FF), D_MODEL ** -0.5)
    mlp_w2 = nrm((DEPTH, D_FF, D_MODEL), D_FF ** -0.5)
    ev_w_in = nrm((ne, D_MODEL, EVEN_IN), D_MODEL ** -0.5)
    ev_q_norm_w = gain((ne, Q_LORA))
    ev_w_uq = nrm((ne, Q_LORA, MLA_HEADS * (MLA_NOPE + MLA_ROPE)), Q_LORA ** -0.5)
    ev_kv_norm_w = gain((ne, KV_LORA))
    ev_w_ukv = nrm((ne, KV_LORA, MLA_HEADS * (MLA_NOPE + MLA_V)), KV_LORA ** -0.5)
    ev_conv_w = nrm((ne, CONV_K, SSM_DINNER + 2 * SSM_GROUPS * SSM_STATE), CONV_K ** -0.5)
    ev_conv_b = nrm((ne, SSM_DINNER + 2 * SSM_GROUPS * SSM_STATE), 0.02)
    dt0 = jnp.exp(jax.random.uniform(next(ks), (ne, 2, SSM_HEADS), f32, math.log(1e-3), math.log(1e-1)))
    ev_dt_bias = dt0 + jnp.log(-jnp.expm1(-dt0))
    ev_a_log = jnp.log(jax.random.uniform(next(ks), (ne, 2, SSM_HEADS), f32, 1.0, 16.0))
    ev_d_skip = gain((ne, SSM_HEADS))
    ev_ssm_norm_w = gain((ne, SSM_DINNER))
    ev_w_out = nrm((ne, MLA_HEADS * MLA_V + SSM_DINNER, D_MODEL), (MLA_HEADS * MLA_V + SSM_DINNER) ** -0.5)
    od_w_in = nrm((no, D_MODEL, ODD_IN), D_MODEL ** -0.5)
    od_conv_w = nrm((no, CONV_K, 2 * MLSTM_QK), CONV_K ** -0.5)
    od_conv_b = nrm((no, 2 * MLSTM_QK), 0.02)
    od_i_bias = nrm((no, 2, MLSTM_HEADS), 0.1)
    od_f_bias = jnp.linspace(3.0, 6.0, MLSTM_HEADS, dtype=f32) + nrm((no, 2, MLSTM_HEADS), 0.1)
    od_head_norm_w = gain((no, MLSTM_VW))
    od_w_out = nrm((no, MLSTM_VW, D_MODEL), MLSTM_VW ** -0.5)
    final_norm_w = gain((D_MODEL,))
    return {'x': x, 'c': c, 'ctx': ctx, 'c_ctx': c_ctx, 'ada_w': ada_w, 'ada_b': ada_b,
            'norm_mix_w': norm_mix_w, 'norm_mlp_w': norm_mlp_w, 'mlp_w1': mlp_w1, 'mlp_w2': mlp_w2,
            'ev_w_in': ev_w_in, 'ev_q_norm_w': ev_q_norm_w, 'ev_w_uq': ev_w_uq, 'ev_kv_norm_w': ev_kv_norm_w,
            'ev_w_ukv': ev_w_ukv, 'ev_conv_w': ev_conv_w, 'ev_conv_b': ev_conv_b, 'ev_dt_bias': ev_dt_bias,
            'ev_a_log': ev_a_log, 'ev_d_skip': ev_d_skip, 'ev_ssm_norm_w': ev_ssm_norm_w, 'ev_w_out': ev_w_out,
            'od_w_in': od_w_in, 'od_conv_w': od_conv_w, 'od_conv_b': od_conv_b, 'od_i_bias': od_i_bias,
            'od_f_bias': od_f_bias, 'od_head_norm_w': od_head_norm_w, 'od_w_out': od_w_out,
            'final_norm_w': final_norm_w}


def reference(x, c, ctx, c_ctx, ada_w, ada_b, norm_mix_w, norm_mlp_w, mlp_w1, mlp_w2,
              ev_w_in, ev_q_norm_w, ev_w_uq, ev_kv_norm_w, ev_w_ukv, ev_conv_w, ev_conv_b,
              ev_dt_bias, ev_a_log, ev_d_skip, ev_ssm_norm_w, ev_w_out,
              od_w_in, od_conv_w, od_conv_b, od_i_bias, od_f_bias, od_head_norm_w, od_w_out,
              final_norm_w):
    rope = rope2d_tables(x.shape[1])
    s_lat = jax.nn.silu(c)
    s_ctx = jax.nn.silu(c_ctx)
    for layer in range(DEPTH):
        last = layer == DEPTH - 1
        sh1, sc1, g1, sh2, sc2, g2 = jnp.split(s_lat @ ada_w[layer] + ada_b[layer], 6, axis=-1)
        csh1, csc1, cg1, csh2, csc2, cg2 = jnp.split(s_ctx @ ada_w[layer] + ada_b[layer], 6, axis=-1)
        h_lat = modulate(rmsnorm(x, norm_mix_w[layer]), sh1[:, None], sc1[:, None])
        h_ctx = modulate(rmsnorm(ctx, norm_mix_w[layer]), csh1, csc1)
        if layer % 2 == 0:
            e = layer // 2
            o_ctx, o_lat = mla_ssd_mixer(h_ctx, h_lat, rope, ev_w_in[e], ev_q_norm_w[e], ev_w_uq[e],
                                         ev_kv_norm_w[e], ev_w_ukv[e], ev_conv_w[e], ev_conv_b[e],
                                         ev_dt_bias[e], ev_a_log[e], ev_d_skip[e], ev_ssm_norm_w[e],
                                         ev_w_out[e], not last)
        else:
            o = layer // 2
            o_ctx, o_lat = mlstm_mixer(h_ctx, h_lat, od_w_in[o], od_conv_w[o], od_conv_b[o], od_i_bias[o],
                                       od_f_bias[o], od_head_norm_w[o], od_w_out[o], not last)
        x = x + g1[:, None] * o_lat
        x = x + g2[:, None] * sqrelu_mlp(modulate(rmsnorm(x, norm_mlp_w[layer]), sh2[:, None], sc2[:, None]),
                                         mlp_w1[layer], mlp_w2[layer])
        if not last:
            ctx = ctx + cg1 * o_ctx
            ctx = ctx + cg2 * sqrelu_mlp(modulate(rmsnorm(ctx, norm_mlp_w[layer]), csh2, csc2),
                                         mlp_w1[layer], mlp_w2[layer])
    return rmsnorm(x, final_norm_w)
```

```cpp
#include <hip/hip_runtime.h>
#include <hip/hip_cooperative_groups.h>
#include <cstdio>
#include <cstdint>
#include <cstring>
namespace cg = cooperative_groups;

#ifndef PHMASK
#define PHMASK 0xFFFFu
#endif
#ifndef DBG_LAYERS
#define DBG_LAYERS 0xF
#endif
#define DBG_NOSTATE 0
#define DBG_DUMP_OFF OFF_HB
#define DBG_DUMP_N ((size_t)8*2048*1024)
#define DBG_DUMP_F32 0
#ifndef RESID_MI
#define RESID_MI 6
#endif
#ifndef SINGLE_LAUNCH
#define SINGLE_LAUNCH 1
#endif

typedef unsigned short bf16_t;
typedef short bf16x8 __attribute__((ext_vector_type(8)));
typedef short bf16x4 __attribute__((ext_vector_type(4)));
typedef float f32x4 __attribute__((ext_vector_type(4)));

constexpr int NT = 512;
constexpr int DM = 1024;
constexpr int NB = 8;
constexpr int LB = 2304;
constexpr int R = NB * LB;
constexpr int NPH = 40;
constexpr float EPS = 1e-6f;
constexpr int LDS_PHASE = 141312;
constexpr int LDS_BYTES = LDS_PHASE + 16;

constexpr size_t SZ_W1 = (size_t)4096 * 1024 * 2, SZ_W2 = SZ_W1;
constexpr size_t SZ_EVIN = (size_t)2304 * 1024 * 2, SZ_UQ = (size_t)768 * 256 * 2, SZ_UKV = (size_t)1024 * 256 * 2, SZ_OUT = (size_t)1024 * 1024 * 2;
constexpr size_t SZ_ODIN = (size_t)3328 * 1024 * 2;
constexpr size_t OFF_W1 = 0;
constexpr size_t OFF_W2 = OFF_W1 + 4 * SZ_W1;
constexpr size_t OFF_EVIN = OFF_W2 + 4 * SZ_W2;
constexpr size_t OFF_UQ = OFF_EVIN + 2 * SZ_EVIN;
constexpr size_t OFF_UKV = OFF_UQ + 2 * SZ_UQ;
constexpr size_t OFF_EVOUT = OFF_UKV + 2 * SZ_UKV;
constexpr size_t OFF_ODIN = OFF_EVOUT + 2 * SZ_OUT;
constexpr size_t OFF_ODOUT = OFF_ODIN + 2 * SZ_ODIN;
constexpr size_t OFF_MOD = OFF_ODOUT + 2 * SZ_OUT;
constexpr size_t OFF_XCTX = OFF_MOD + (size_t)4 * 9 * 6144 * 4;
constexpr size_t OFF_H = OFF_XCTX + (size_t)2048 * 1024 * 4;
constexpr size_t OFF_XB = OFF_H;
constexpr size_t OFF_S = OFF_H + (size_t)R * 1024 * 2;
constexpr size_t SZ_S = (size_t)R * 4096 * 2;
constexpr size_t OFF_GATES = OFF_S + SZ_S;
constexpr size_t OFF_M = OFF_GATES + (size_t)R * 32 * 4;
constexpr size_t OFF_UE = OFF_S;
constexpr size_t OFF_Y = OFF_UE + (size_t)R * 2304 * 2;
constexpr size_t OFF_Q = OFF_Y + (size_t)2 * R * 512 * 2;
static_assert(OFF_Q + (size_t)R * 768 * 2 <= OFF_S + SZ_S, "S overflow even");
constexpr size_t OFF_KN = OFF_M;
constexpr size_t OFF_KR = OFF_KN + (size_t)R * 512 * 2;
constexpr size_t OFF_VTE = OFF_KR + (size_t)R * 32 * 2;
constexpr size_t OFF_XT = OFF_VTE + (size_t)R * 512 * 2;
constexpr size_t OFF_BM = OFF_XT + (size_t)R * 512 * 2;
constexpr size_t OFF_BMT = OFF_BM + (size_t)R * 256 * 2;
constexpr size_t OFF_CM = OFF_BMT + (size_t)R * 256 * 2;
constexpr size_t OFF_DT = OFF_CM + (size_t)R * 256 * 2;
constexpr size_t OFF_DA = OFF_DT + (size_t)R * 16 * 4;
constexpr size_t END_EVEN = OFF_DA + (size_t)R * 16 * 4;
constexpr size_t OFF_UO = OFF_S;
constexpr size_t OFF_HB = OFF_UO + (size_t)R * 2048 * 2;
static_assert(OFF_HB + (size_t)2 * R * 1024 * 2 <= OFF_S + SZ_S, "S overflow odd");
constexpr size_t OFF_QC = OFF_M;
constexpr size_t OFF_KC = OFF_QC + (size_t)R * 512 * 2;
constexpr size_t OFF_KT = OFF_KC + (size_t)R * 512 * 2;
constexpr size_t OFF_VTO = OFF_KT + (size_t)R * 512 * 2;
constexpr size_t END_ODD = OFF_VTO + (size_t)R * 1024 * 2;
constexpr size_t WS_NEED = END_ODD > END_EVEN ? END_ODD : END_EVEN;
constexpr size_t OFF_BAR = (WS_NEED + 255) / 256 * 256;
constexpr size_t WS_TOTAL = OFF_BAR + 16384;
static_assert(WS_TOTAL <= (size_t)402000000, "workspace too large");

struct WDesc { const float* src; bf16_t* dst; int K, N, Npad, tstart; };

struct Params {
  const float *x, *c, *ctx, *c_ctx, *ada_w, *ada_b, *norm_mix_w, *norm_mlp_w, *mlp_w1, *mlp_w2;
  const float *ev_w_in, *ev_q_norm_w, *ev_w_uq, *ev_kv_norm_w, *ev_w_ukv, *ev_conv_w, *ev_conv_b, *ev_dt_bias, *ev_a_log, *ev_d_skip, *ev_ssm_norm_w, *ev_w_out;
  const float *od_w_in, *od_conv_w, *od_conv_b, *od_i_bias, *od_f_bias, *od_head_norm_w, *od_w_out, *final_norm_w;
  float* out; char* ws;
  int ph_begin, ph_end, coop, pad0;
};

__device__ __forceinline__ int tidx() { int t = threadIdx.x; asm volatile("" : "+v"(t)); return t; }
__device__ __forceinline__ int bidx() { int t = blockIdx.x; asm volatile("" : "+s"(t)); return t; }
__device__ __forceinline__ unsigned short f2bf(float f) {
  unsigned u = __float_as_uint(f);
  u += 0x7fffu + ((u >> 16) & 1u);
  return (unsigned short)(u >> 16);
}
__device__ __forceinline__ float bf2f(unsigned short h) { return __uint_as_float(((unsigned)h) << 16); }
__device__ __forceinline__ unsigned pack2(float a, float b) { unsigned r; asm("v_cvt_pk_bf16_f32 %0, %1, %2" : "=v"(r) : "v"(a), "v"(b)); return r; }
__device__ __forceinline__ uint2 pack4(f32x4 v) { return make_uint2(pack2(v[0], v[1]), pack2(v[2], v[3])); }
__device__ __forceinline__ bf16x8 pack8(f32x4 a, f32x4 b) {
  union { bf16x8 v; unsigned u[4]; } r;
  r.u[0] = pack2(a[0], a[1]); r.u[1] = pack2(a[2], a[3]); r.u[2] = pack2(b[0], b[1]); r.u[3] = pack2(b[2], b[3]);
  return r.v;
}
__device__ __forceinline__ bf16x8 cat44(uint2 a, uint2 b) {
  union { bf16x8 v; unsigned u[4]; } r;
  r.u[0] = a.x; r.u[1] = a.y; r.u[2] = b.x; r.u[3] = b.y;
  return r.v;
}
__device__ __forceinline__ f32x4 mfma16(bf16x8 a, bf16x8 b, f32x4 c) { return __builtin_amdgcn_mfma_f32_16x16x32_bf16(a, b, c, 0, 0, 0); }
__device__ __forceinline__ float wave_sum(float v) {
#pragma unroll
  for (int o = 32; o > 0; o >>= 1) v += __shfl_xor(v, o);
  return v;
}
__device__ __forceinline__ float scan_add(float v, int lane) {
#pragma unroll
  for (int o = 1; o < 64; o <<= 1) { float t = __shfl_up(v, o); if (lane >= o) v += t; }
  return v;
}
__device__ __forceinline__ float scan_max(float v, int lane) {
#pragma unroll
  for (int o = 1; o < 64; o <<= 1) { float t = __shfl_up(v, o); if (lane >= o) v = fmaxf(v, t); }
  return v;
}
__device__ __forceinline__ float siluf(float v) { return v * __builtin_amdgcn_rcpf(1.f + __expf(-v)); }
__device__ __forceinline__ float sigmoidf(float v) { return __builtin_amdgcn_rcpf(1.f + __expf(-v)); }
__device__ __forceinline__ float softplusf(float v) { return fmaxf(v, 0.f) + __logf(1.f + __expf(-fabsf(v))); }
__device__ __forceinline__ float* xrow(const Params& p, int r) {
  int b = r / LB, s = r - b * LB;
  return s < 2048 ? p.out + (size_t)(b * 2048 + s) * DM : (float*)(p.ws + OFF_XCTX) + (size_t)(b * 256 + (s - 2048)) * DM;
}
__device__ __forceinline__ void rope8(const float* own, const float* par, float pos, bool hi, float* o) {
  const float inv[8] = {1.f, 0.316227766f, 0.1f, 0.0316227766f, 0.01f, 0.00316227766f, 0.001f, 0.000316227766f};
#pragma unroll
  for (int i = 0; i < 8; ++i) {
    float ang = pos * inv[i];
    float k = rintf(ang * 0.15915494309f);
    ang = ang - k * 6.28318530718f;
    float sn = __sinf(ang), cs = __cosf(ang);
    o[i] = hi ? own[i] * cs + par[i] * sn : own[i] * cs - par[i] * sn;
  }
}
__device__ __forceinline__ void unpack8(uint4 v, float* f) {
  f[0] = __uint_as_float(v.x << 16); f[1] = __uint_as_float(v.x & 0xffff0000u);
  f[2] = __uint_as_float(v.y << 16); f[3] = __uint_as_float(v.y & 0xffff0000u);
  f[4] = __uint_as_float(v.z << 16); f[5] = __uint_as_float(v.z & 0xffff0000u);
  f[6] = __uint_as_float(v.w << 16); f[7] = __uint_as_float(v.w & 0xffff0000u);
}
__device__ __forceinline__ uint4 packf8(const float* f) {
  return make_uint4(pack2(f[0], f[1]), pack2(f[2], f[3]), pack2(f[4], f[5]), pack2(f[6], f[7]));
}

__device__ void wt_tile_wave(const WDesc w, int t) {
  const int lane = tidx() & 63;
  const int nkt = w.K >> 6;
  const int ntile = t / nkt, ktile = t - ntile * nkt;
  const int kb = lane & 7, nb = lane >> 3;
  const int k0 = ktile * 64 + kb * 8, n0 = ntile * 64 + nb * 8;
  float v[8][8];
  if (n0 + 8 <= w.N) {
#pragma unroll
    for (int kk = 0; kk < 8; ++kk) {
      const float* src = w.src + (size_t)(k0 + kk) * w.N + n0;
      float4 a = *(const float4*)src, b = *(const float4*)(src + 4);
      v[kk][0] = a.x; v[kk][1] = a.y; v[kk][2] = a.z; v[kk][3] = a.w; v[kk][4] = b.x; v[kk][5] = b.y; v[kk][6] = b.z; v[kk][7] = b.w;
    }
  } else {
#pragma unroll
    for (int kk = 0; kk < 8; ++kk)
#pragma unroll
      for (int e = 0; e < 8; ++e) v[kk][e] = 0.f;
  }
#pragma unroll
  for (int e = 0; e < 8; ++e) {
    uint4 o = make_uint4(pack2(v[0][e], v[1][e]), pack2(v[2][e], v[3][e]), pack2(v[4][e], v[5][e]), pack2(v[6][e], v[7][e]));
    *(uint4*)(w.dst + (size_t)(n0 + e) * w.K + k0) = o;
  }
}

__device__ void ada_tile(const Params& p, int t, char* smem) {
  const int tid = tidx(), lane = tid & 63, wave = __builtin_amdgcn_readfirstlane(tid >> 6);
  const int l = t / 192, cgp = t - l * 192;
  float* sv = (float*)smem;
  float* red = sv + 9 * 1024;
  for (int idx = tid; idx < 9 * 1024; idx += NT) {
    int r = idx >> 10, k = idx & 1023;
    float v = r < 8 ? p.c[r * 1024 + k] : p.c_ctx[k];
    sv[idx] = siluf(v);
  }
  __syncthreads();
  const int cl = lane & 7, rg = lane >> 3;
  const float* wp = p.ada_w + (size_t)l * 1024 * 6144 + cgp * 32 + cl * 4;
  const int kb = wave * 128 + rg;
  float4 wv[16];
#pragma unroll
  for (int it = 0; it < 16; ++it) wv[it] = *(const float4*)(wp + (size_t)(kb + it * 8) * 6144);
  float acc[9][4];
#pragma unroll
  for (int r = 0; r < 9; ++r) { acc[r][0] = 0.f; acc[r][1] = 0.f; acc[r][2] = 0.f; acc[r][3] = 0.f; }
#pragma unroll
  for (int it = 0; it < 16; ++it) {
    const int k = kb + it * 8;
#pragma unroll
    for (int r = 0; r < 9; ++r) {
      const float sx = sv[r * 1024 + k];
      acc[r][0] += sx * wv[it].x; acc[r][1] += sx * wv[it].y; acc[r][2] += sx * wv[it].z; acc[r][3] += sx * wv[it].w;
    }
  }
#pragma unroll
  for (int r = 0; r < 9; ++r)
#pragma unroll
    for (int e = 0; e < 4; ++e) {
      float v = acc[r][e];
      v += __shfl_xor(v, 8); v += __shfl_xor(v, 16); v += __shfl_xor(v, 32);
      acc[r][e] = v;
    }
  if (rg == 0) {
#pragma unroll
    for (int r = 0; r < 9; ++r)
#pragma unroll
      for (int e = 0; e < 4; ++e) red[(wave * 9 + r) * 32 + cl * 4 + e] = acc[r][e];
  }
  __syncthreads();
  float* mod = (float*)(p.ws + OFF_MOD);
  if (tid < 9 * 32) {
    int r = tid >> 5, cc = tid & 31;
    float sacc = 0.f;
#pragma unroll
    for (int w = 0; w < 8; ++w) sacc += red[(w * 9 + r) * 32 + cc];
    mod[((size_t)l * 9 + r) * 6144 + cgp * 32 + cc] = sacc + p.ada_b[l * 6144 + cgp * 32 + cc];
  }
  __syncthreads();
}

__device__ __forceinline__ bool wsel(int& tt, int cnt, int per, int& idx) {
  if (tt < cnt * per) { idx = tt / per; tt -= idx * per; return true; }
  tt -= cnt * per; return false;
}
constexpr int N_WTILES = 4 * 1024 + 4 * 1024 + 2 * (576 + 48 + 64 + 256 + 832 + 256);
__device__ void setup_phase(const Params& p, char* smem) {
  for (int t = bidx(); t < 768; t += gridDim.x) ada_tile(p, t, smem);
  const int wave = __builtin_amdgcn_readfirstlane(tidx() >> 6);
  for (int t = bidx() * 8 + wave; t < N_WTILES; t += gridDim.x * 8) {
    int tt = t, i = 0;
    WDesc w; w.tstart = 0;
    if (wsel(tt, 4, 1024, i)) { w.src = p.mlp_w1 + (size_t)i * 1024 * 4096; w.dst = (bf16_t*)(p.ws + OFF_W1 + i * SZ_W1); w.K = 1024; w.N = 4096; }
    else if (wsel(tt, 4, 1024, i)) { w.src = p.mlp_w2 + (size_t)i * 1024 * 4096; w.dst = (bf16_t*)(p.ws + OFF_W2 + i * SZ_W2); w.K = 4096; w.N = 1024; }
    else if (wsel(tt, 2, 576, i)) { w.src = p.ev_w_in + (size_t)i * 1024 * 2096; w.dst = (bf16_t*)(p.ws + OFF_EVIN + i * SZ_EVIN); w.K = 1024; w.N = 2096; }
    else if (wsel(tt, 2, 48, i)) { w.src = p.ev_w_uq + (size_t)i * 256 * 768; w.dst = (bf16_t*)(p.ws + OFF_UQ + i * SZ_UQ); w.K = 256; w.N = 768; }
    else if (wsel(tt, 2, 64, i)) { w.src = p.ev_w_ukv + (size_t)i * 256 * 1024; w.dst = (bf16_t*)(p.ws + OFF_UKV + i * SZ_UKV); w.K = 256; w.N = 1024; }
    else if (wsel(tt, 2, 256, i)) { w.src = p.ev_w_out + (size_t)i * 1024 * 1024; w.dst = (bf16_t*)(p.ws + OFF_EVOUT + i * SZ_OUT); w.K = 1024; w.N = 1024; }
    else if (wsel(tt, 2, 832, i)) { w.src = p.od_w_in + (size_t)i * 1024 * 3104; w.dst = (bf16_t*)(p.ws + OFF_ODIN + i * SZ_ODIN); w.K = 1024; w.N = 3104; }
    else { wsel(tt, 2, 256, i); w.src = p.od_w_out + (size_t)i * 1024 * 1024; w.dst = (bf16_t*)(p.ws + OFF_ODOUT + i * SZ_OUT); w.K = 1024; w.N = 1024; }
    w.Npad = 0;
    wt_tile_wave(w, tt);
  }
  bf16_t* xbw = (bf16_t*)(p.ws + OFF_XB);
  for (size_t i = (size_t)bidx() * NT + tidx(); i < (size_t)R * DM / 8; i += (size_t)gridDim.x * NT) {
    const int r = (int)(i >> 7), c8 = (int)(i & 127) * 8;
    const int b = r / LB, sq = r - b * LB;
    const float* src = (sq < 2048 ? p.x + (size_t)(b * 2048 + sq) * DM : p.ctx + (size_t)(b * 256 + (sq - 2048)) * DM) + c8;
    const float4 f0 = *(const float4*)src, f1 = *(const float4*)(src + 4);
    *(uint4*)(xbw + (size_t)r * DM + c8) = make_uint4(pack2(f0.x, f0.y), pack2(f0.z, f0.w), pack2(f1.x, f1.y), pack2(f1.z, f1.w));
  }
}

__device__ void norm_phase(const Params& p, int layer, int which, bool skip_ctx) {
  const int lane = tidx() & 63, wave = __builtin_amdgcn_readfirstlane(tidx() >> 6);
  const float* w = (which ? p.norm_mlp_w : p.norm_mix_w) + layer * DM;
  const float* mod = (const float*)(p.ws + OFF_MOD) + (size_t)layer * 9 * 6144;
  bf16_t* h = (bf16_t*)((char*)p.out);
  for (int r = bidx() * 8 + wave; r < R; r += gridDim.x * 8) {
    int b = r / LB, s = r - b * LB;
    if (skip_ctx && s >= 2048) continue;
    int mr = s < 2048 ? b : 8;
    const bf16_t* xr = (const bf16_t*)(p.ws + OFF_XB) + (size_t)r * DM;
    float4 v[4]; float ss = 0.f;
    uint2 q_[4];
#pragma unroll
    for (int i = 0; i < 4; ++i) q_[i] = *(const uint2*)(xr + i * 256 + lane * 4);
#pragma unroll
    for (int i = 0; i < 4; ++i) {
      v[i].x = __uint_as_float(q_[i].x << 16); v[i].y = __uint_as_float(q_[i].x & 0xffff0000u);
      v[i].z = __uint_as_float(q_[i].y << 16); v[i].w = __uint_as_float(q_[i].y & 0xffff0000u);
      ss += v[i].x * v[i].x + v[i].y * v[i].y + v[i].z * v[i].z + v[i].w * v[i].w;
    }
    ss = wave_sum(ss);
    float rstd = rsqrtf(ss * (1.f / 1024.f) + EPS);
    const float* sh = mod + (size_t)mr * 6144 + (which ? 3072 : 0);
    const float* sc = sh + 1024;
#pragma unroll
    for (int i = 0; i < 4; ++i) {
      int col = i * 256 + lane * 4;
      float4 w4 = *(const float4*)(w + col), s4 = *(const float4*)(sh + col), c4 = *(const float4*)(sc + col);
      f32x4 o;
      o[0] = v[i].x * rstd * w4.x * (1.f + c4.x) + s4.x;
      o[1] = v[i].y * rstd * w4.y * (1.f + c4.y) + s4.y;
      o[2] = v[i].z * rstd * w4.z * (1.f + c4.z) + s4.z;
      o[3] = v[i].w * rstd * w4.w * (1.f + c4.w) + s4.w;
      *(uint2*)(h + (size_t)r * DM + col) = pack4(o);
    }
  }
}

__device__ void final_phase(const Params& p) {
  const int lane = tidx() & 63, wave = __builtin_amdgcn_readfirstlane(tidx() >> 6);
  for (int r = bidx() * 8 + wave; r < NB * 2048; r += gridDim.x * 8) {
    const int b = r >> 11, t = r & 2047;
    const bf16_t* xr = (const bf16_t*)(p.ws + OFF_XB) + (size_t)(b * LB + t) * DM;
    float4 v[4]; float ss = 0.f;
    uint2 q_[4];
#pragma unroll
    for (int i = 0; i < 4; ++i) q_[i] = *(const uint2*)(xr + i * 256 + lane * 4);
#pragma unroll
    for (int i = 0; i < 4; ++i) {
      v[i].x = __uint_as_float(q_[i].x << 16); v[i].y = __uint_as_float(q_[i].x & 0xffff0000u);
      v[i].z = __uint_as_float(q_[i].y << 16); v[i].w = __uint_as_float(q_[i].y & 0xffff0000u);
      ss += v[i].x * v[i].x + v[i].y * v[i].y + v[i].z * v[i].z + v[i].w * v[i].w;
    }
    ss = wave_sum(ss);
    float rstd = rsqrtf(ss * (1.f / 1024.f) + EPS);
#pragma unroll
    for (int i = 0; i < 4; ++i) {
      int col = i * 256 + lane * 4;
      float4 w4 = *(const float4*)(p.final_norm_w + col);
      float4 o = make_float4(v[i].x * rstd * w4.x, v[i].y * rstd * w4.y, v[i].z * rstd * w4.z, v[i].w * rstd * w4.w);
      *(float4*)(p.out + (size_t)r * DM + col) = o;
    }
  }
}

enum { EPI_U_EVEN = 0, EPI_U_ODD, EPI_Q, EPI_KV, EPI_RESID, EPI_SQRELU };
struct GemmDesc { const bf16_t* A; int lda; const bf16_t* W; int K; int ntn; int epi; int layer; int gate_off; int skip_ctx; };

__device__ __forceinline__ int lds_byte2(int r, int c) {
  int st = (r >> 4) * 2 + (c >> 5), ob = (r & 15) * 64 + (c & 31) * 2;
  return st * 1024 + (ob ^ (((ob >> 9) & 1) << 5));
}
__device__ __forceinline__ void stage_rc2(int b, int& R, int& C) {
  int st = b >> 10, sb = b & 1023, swz = sb ^ (((sb >> 9) & 1) << 5);
  R = (st >> 1) * 16 + swz / 64;
  C = (st & 1) * 32 + (swz % 64) / 2;
}
#define GLDS16(gp, lp) __builtin_amdgcn_global_load_lds((const __attribute__((address_space(1))) unsigned*)(gp), (__attribute__((address_space(3))) unsigned*)(lp), 16, 0, 0)

__device__ void gemm_tile(const Params& p, const GemmDesc& g, int mt, int nt, char* smem, const int nrt,
                          const bf16_t* Ag_n, const bf16_t* Wg_n, const bool has_next, const bool first) {
  constexpr int MI = 8;
  const int BMR = nrt * 16;
  const int TA = BMR * 128;
  constexpr int TB = 256 * 128;
  const int STG = TA + TB;
  constexpr int GLB = TB / 8192;
  const int tid = tidx(), lane = tid & 63, wave = __builtin_amdgcn_readfirstlane(tid >> 6), l15 = lane & 15, quad = lane >> 4;
  const int wm = wave >> 2, wn = wave & 3;
  const int base_rt = wm * ((nrt + 1) >> 1);
  const int cnt = wm ? (nrt >> 1) : ((nrt + 1) >> 1);
  const int m0 = mt * BMR, n0 = nt * 256;
  const int K = g.K, lda = g.lda;
  const bf16_t* Ag = g.A + (size_t)m0 * lda;
  const bf16_t* Wg = g.W + (size_t)n0 * K;
  f32x4 acc[MI][4];
#pragma unroll
  for (int i = 0; i < MI; ++i)
#pragma unroll
    for (int j = 0; j < 4; ++j) acc[i][j] = (f32x4){0.f, 0.f, 0.f, 0.f};
  const int nk = K >> 6;
  const int nw = n0 + wn * 64;
  int R0, C0;
  stage_rc2(wave * 1024 + lane * 16, R0, C0);
  const int R0b = (R0 & ~31) + 8 * ((R0 & 15) >> 2) + 4 * ((R0 >> 4) & 1) + (R0 & 3);
  const int offA = R0 * lda + C0, offB = R0b * K + C0;
#define GSTAGE(A_, W_, buf, kt) do { \
    const bf16_t* ak_ = (A_) + (kt) * 64; const bf16_t* wk_ = (W_) + (kt) * 64; \
    _Pragma("unroll") for (int i_ = 0; i_ < GLB; ++i_) if (wave + 8 * i_ < 2 * nrt) GLDS16(ak_ + (size_t)(i_ * 64) * lda + offA, smem + (buf) * STG + wave * 1024 + i_ * 8192); \
    _Pragma("unroll") for (int i_ = 0; i_ < GLB; ++i_) GLDS16(wk_ + (size_t)(i_ * 64) * K + offB, smem + (buf) * STG + TA + wave * 1024 + i_ * 8192); } while (0)
  const int ob_ = l15 * 64 + quad * 16;
  const int lane_off = ob_ ^ (((ob_ >> 9) & 1) << 5);
  const int a_off = lane_off + base_rt * 2048;
  const int b_off = lane_off + TA + (wn * 4) * 2048;
#define LDA_LO(A_, base, ks) do { _Pragma("unroll") for (int i_ = 0; i_ < 4; ++i_) A_[i_] = *(const bf16x8*)((base) + a_off + (i_ * 2 + (ks)) * 1024); } while (0)
#define LDA_HI(A_, base, ks) do { if (cnt > 4) { A_[0] = *(const bf16x8*)((base) + a_off + (4 * 2 + (ks)) * 1024); \
    if (cnt > 5) { A_[1] = *(const bf16x8*)((base) + a_off + (5 * 2 + (ks)) * 1024); \
    if (cnt == 8) { _Pragma("unroll") for (int i_ = 6; i_ < 8; ++i_) A_[i_ - 4] = *(const bf16x8*)((base) + a_off + (i_ * 2 + (ks)) * 1024); } } } } while (0)
#define LDB_F(B_, base, ks) do { _Pragma("unroll") for (int j_ = 0; j_ < 4; ++j_) B_[j_] = *(const bf16x8*)((base) + b_off + (j_ * 2 + (ks)) * 1024); } while (0)
#define MMA_LO(A_, B_) do { _Pragma("unroll") for (int i_ = 0; i_ < 4; ++i_) { _Pragma("unroll") for (int j_ = 0; j_ < 4; ++j_) acc[i_][j_] = mfma16(B_[j_], A_[i_], acc[i_][j_]); } } while (0)
#define MMA_HI(A_, B_) do { if (cnt > 4) { _Pragma("unroll") for (int j_ = 0; j_ < 4; ++j_) acc[4][j_] = mfma16(B_[j_], A_[0], acc[4][j_]); \
    if (cnt > 5) { _Pragma("unroll") for (int j_ = 0; j_ < 4; ++j_) acc[5][j_] = mfma16(B_[j_], A_[1], acc[5][j_]); \
    if (cnt == 8) { _Pragma("unroll") for (int i_ = 6; i_ < 8; ++i_) { _Pragma("unroll") for (int j_ = 0; j_ < 4; ++j_) acc[i_][j_] = mfma16(B_[j_], A_[i_ - 4], acc[i_][j_]); } } } } } while (0)
#define SB_ __builtin_amdgcn_sched_barrier(0)
  bf16x8 aL[4], aH[4], bX[4], bY[4];
  if (first) GSTAGE(Ag, Wg, 0, 0);
  asm volatile("s_waitcnt vmcnt(0)" ::: "memory");
  __syncthreads();
  LDA_LO(aL, smem, 0); LDB_F(bX, smem, 0);
#pragma unroll 1
  for (int kt = 0; kt < nk; ++kt) {
    const int buf = kt & 1;
    const char* cur = smem + buf * STG;
    const char* nxt = smem + (buf ^ 1) * STG;
    if (kt + 1 < nk) GSTAGE(Ag, Wg, buf ^ 1, kt + 1);
    else if (has_next) GSTAGE(Ag_n, Wg_n, buf ^ 1, 0);
    LDA_HI(aH, cur, 0); SB_; MMA_LO(aL, bX); SB_;
    LDA_LO(aL, cur, 1); LDB_F(bY, cur, 1); SB_; MMA_HI(aH, bX); SB_;
    LDA_HI(aH, cur, 1); SB_; MMA_LO(aL, bY); SB_;
    asm volatile("s_waitcnt vmcnt(0)" ::: "memory");
    __syncthreads();
    if (kt + 1 < nk) { LDA_LO(aL, nxt, 0); LDB_F(bX, nxt, 0); }
    SB_; MMA_HI(aH, bY); SB_;
  }
#undef LDA_LO
#undef LDA_HI
#undef LDB_F
#undef MMA_LO
#undef MMA_HI
#undef SB_
#undef GSTAGE

  const float* mod = (const float*)(p.ws + OFF_MOD) + (size_t)g.layer * 9 * 6144;
#pragma unroll
  for (int i = 0; i < MI; ++i) {
    if (i >= cnt) break;
    const int m = m0 + (base_rt + i) * 16 + l15;
    const int bb_ = m / LB, ss_ = m - bb_ * LB;
#pragma unroll
    for (int t = 0; t < 2; ++t) {
      const f32x4 v0 = acc[i][2 * t], v1 = acc[i][2 * t + 1];
      const int n = nw + t * 32 + quad * 8;
      const uint4 pk = make_uint4(pack2(v0[0], v0[1]), pack2(v0[2], v0[3]), pack2(v1[0], v1[1]), pack2(v1[2], v1[3]));
      switch (g.epi) {
        case EPI_U_EVEN: {
          if (n < 2096) *(uint4*)((bf16_t*)(p.ws + OFF_UE) + (size_t)m * 2304 + n) = pk;
          if (n >= 2080 && n < 2096) {
            float* gp = (float*)(p.ws + OFF_GATES) + (size_t)m * 32 + (n - 2080);
            *(float4*)gp = make_float4(v0[0], v0[1], v0[2], v0[3]); *(float4*)(gp + 4) = make_float4(v1[0], v1[1], v1[2], v1[3]);
          }
        } break;
        case EPI_U_ODD: {
          if (n < 1024) *(uint4*)((bf16_t*)(p.ws + OFF_UO) + (size_t)m * 2048 + n) = pk;
          else if (n < 2048) {
            bf16_t* vt = (bf16_t*)(p.ws + OFF_VTO) + ((size_t)(bb_ * 1024 + (n - 1024))) * LB + ss_;
            vt[0] = (bf16_t)(pk.x & 0xffffu); vt[(size_t)1 * LB] = (bf16_t)(pk.x >> 16); vt[(size_t)2 * LB] = (bf16_t)(pk.y & 0xffffu); vt[(size_t)3 * LB] = (bf16_t)(pk.y >> 16);
            vt[(size_t)4 * LB] = (bf16_t)(pk.z & 0xffffu); vt[(size_t)5 * LB] = (bf16_t)(pk.z >> 16); vt[(size_t)6 * LB] = (bf16_t)(pk.w & 0xffffu); vt[(size_t)7 * LB] = (bf16_t)(pk.w >> 16);
          }
          else if (n < 3072) *(uint4*)((bf16_t*)(p.ws + OFF_UO) + (size_t)m * 2048 + (n - 1024)) = pk;
          else if (n < 3104) {
            float* gp = (float*)(p.ws + OFF_GATES) + (size_t)m * 32 + (n - 3072);
            *(float4*)gp = make_float4(v0[0], v0[1], v0[2], v0[3]); *(float4*)(gp + 4) = make_float4(v1[0], v1[1], v1[2], v1[3]);
          }
        } break;
        case EPI_Q: {
          *(uint4*)((bf16_t*)(p.ws + OFF_Q) + (size_t)m * 768 + n) = pk;
        } break;
        case EPI_KV: {
          const int hh = n >> 7, wi = n & 127;
          if (wi < 64) *(uint4*)((bf16_t*)(p.ws + OFF_KN) + (size_t)m * 512 + hh * 64 + wi) = pk;
          else {
            bf16_t* vt = (bf16_t*)(p.ws + OFF_VTE) + ((size_t)(bb_ * 512 + hh * 64 + (wi - 64))) * LB + ss_;
            vt[0] = (bf16_t)(pk.x & 0xffffu); vt[(size_t)1 * LB] = (bf16_t)(pk.x >> 16); vt[(size_t)2 * LB] = (bf16_t)(pk.y & 0xffffu); vt[(size_t)3 * LB] = (bf16_t)(pk.y >> 16);
            vt[(size_t)4 * LB] = (bf16_t)(pk.z & 0xffffu); vt[(size_t)5 * LB] = (bf16_t)(pk.z >> 16); vt[(size_t)6 * LB] = (bf16_t)(pk.w & 0xffffu); vt[(size_t)7 * LB] = (bf16_t)(pk.w >> 16);
          }
        } break;
        case EPI_RESID: {
          const int mr = ss_ < 2048 ? bb_ : 8;
          const float* gp = mod + (size_t)mr * 6144 + g.gate_off + n;
          const float4 g0 = *(const float4*)gp, g1 = *(const float4*)(gp + 4);
          bf16_t* xp = (bf16_t*)(p.ws + OFF_XB) + (size_t)m * DM + n;
          float xf[8]; unpack8(*(const uint4*)xp, xf);
          xf[0] += g0.x * v0[0]; xf[1] += g0.y * v0[1]; xf[2] += g0.z * v0[2]; xf[3] += g0.w * v0[3];
          xf[4] += g1.x * v1[0]; xf[5] += g1.y * v1[1]; xf[6] += g1.z * v1[2]; xf[7] += g1.w * v1[3];
          *(uint4*)xp = packf8(xf);
        } break;
        case EPI_SQRELU: {
          float q[8];
#pragma unroll
          for (int e = 0; e < 4; ++e) { float a_ = fmaxf(v0[e], 0.f), b_ = fmaxf(v1[e], 0.f); q[e] = a_ * a_; q[4 + e] = b_ * b_; }
          *(uint4*)((bf16_t*)(p.ws + OFF_S) + (size_t)m * 4096 + n) = make_uint4(pack2(q[0], q[1]), pack2(q[2], q[3]), pack2(q[4], q[5]), pack2(q[6], q[7]));
        } break;
      }
    }
  }
}

__device__ void conv_tile(const Params& p, int layer, bool even, int tt, int cgp, char* smem, const float (&wreg)[5][16], const float (&breg)[16]) {
  const int tid = tidx();
  const int tok = tid >> 3, sub = tid & 7;
  const int r0 = tt * 64, r = r0 + tok;
  const int b = r / LB, s = r - b * LB;
  const int lo = s < 2048 ? 0 : 2048, hi = s < 2048 ? 2048 : LB;
  const int li = layer >> 1;
  const int ch0 = cgp * 128 + sub * 16;
  const bf16_t* ub; int ldu;
  if (even) { ub = (const bf16_t*)(p.ws + OFF_UE) + 1056; ldu = 2304; }
  else { ub = (const bf16_t*)(p.ws + OFF_UO); ldu = 2048; }
  (void)li;
  float acc[16];
#pragma unroll
  for (int q = 0; q < 16; ++q) acc[q] = breg[q];
#pragma unroll
  for (int j = 0; j < 5; ++j) {
    int ss = s + j - 2;
    if (ss >= lo && ss < hi) {
      const bf16_t* src = ub + (size_t)(r + j - 2) * ldu + ch0;
      uint4 x0 = *(const uint4*)src, x1 = *(const uint4*)(src + 8);
      float xf[16]; unpack8(x0, xf); unpack8(x1, xf + 8);
#pragma unroll
      for (int q = 0; q < 16; ++q) acc[q] += wreg[j][q] * xf[q];
    }
  }
  const bool kscale = (!even) && cgp >= 4;
#pragma unroll
  for (int e = 0; e < 16; ++e) { float v = siluf(acc[e]); acc[e] = kscale ? v * 0.125f : v; }
  bf16_t* rm = nullptr; int ldr = 0, coff = 0;
  bf16_t* tr = nullptr; int trows = 0, troff = 0;
  if (even) {
    if (cgp < 4) { tr = (bf16_t*)(p.ws + OFF_XT); trows = 512; troff = cgp * 128; }
    else if (cgp < 6) { rm = (bf16_t*)(p.ws + OFF_BM); ldr = 256; coff = (cgp - 4) * 128; tr = (bf16_t*)(p.ws + OFF_BMT); trows = 256; troff = (cgp - 4) * 128; }
    else { rm = (bf16_t*)(p.ws + OFF_CM); ldr = 256; coff = (cgp - 6) * 128; }
  } else {
    if (cgp < 4) { rm = (bf16_t*)(p.ws + OFF_QC); ldr = 512; coff = cgp * 128; }
    else { rm = (bf16_t*)(p.ws + OFF_KC); ldr = 512; coff = (cgp - 4) * 128; tr = (bf16_t*)(p.ws + OFF_KT); trows = 512; troff = (cgp - 4) * 128; }
  }
  if (rm) {
    bf16_t* dst = rm + (size_t)r * ldr + coff + sub * 16;
    *(uint4*)dst = packf8(acc); *(uint4*)(dst + 8) = packf8(acc + 8);
  }
  if (tr) {
    bf16_t* T = (bf16_t*)smem;
#pragma unroll
    for (int e = 0; e < 16; ++e) T[(sub * 16 + e) * 72 + tok] = f2bf(acc[e]);
    __syncthreads();
    const int s0 = r0 - (r0 / LB) * LB, b0 = r0 / LB;
#pragma unroll
    for (int i = 0; i < 2; ++i) {
      int idx = tid + i * NT; int chl = idx >> 3, tc = idx & 7;
      *(uint4*)(tr + ((size_t)(b0 * trows + troff + chl)) * LB + s0 + tc * 8) = *(const uint4*)&T[chl * 72 + tc * 8];
    }
    __syncthreads();
  }
}

__device__ void misc_tile(const Params& p, int layer, int tt) {
  const int tid = tidx();
  const int tok = tid >> 3, sub = tid & 7;
  const int r = tt * 64 + tok;
  const int b = r / LB, s = r - b * LB;
  const int e = layer >> 1;
  bf16_t* u = (bf16_t*)(p.ws + OFF_UE) + (size_t)r * 2304;
#pragma unroll
  for (int part = 0; part < 2; ++part) {
    bf16_t* src = u + part * 256 + sub * 32;
    const float* nw = (part ? p.ev_kv_norm_w : p.ev_q_norm_w) + e * 256 + sub * 32;
    float f[32];
#pragma unroll
    for (int q = 0; q < 4; ++q) unpack8(*(const uint4*)(src + q * 8), f + q * 8);
    float ss = 0.f;
#pragma unroll
    for (int q = 0; q < 32; ++q) ss += f[q] * f[q];
    ss += __shfl_xor(ss, 1); ss += __shfl_xor(ss, 2); ss += __shfl_xor(ss, 4);
    float rstd = rsqrtf(ss * (1.f / 256.f) + EPS);
#pragma unroll
    for (int q = 0; q < 32; ++q) f[q] = f[q] * rstd * nw[q];
#pragma unroll
    for (int q = 0; q < 4; ++q) *(uint4*)(src + q * 8) = packf8(f + q * 8);
  }
  if (sub < 4) {
    const int gsel = sub >> 1; const bool hi = sub & 1;
    float x1[8], x2[8], o[8];
    unpack8(*(const uint4*)(u + 512 + gsel * 16), x1);
    unpack8(*(const uint4*)(u + 512 + gsel * 16 + 8), x2);
    if (s < 2048) {
      float pos = (float)(gsel ? (s & 63) : (s >> 6));
      rope8(hi ? x2 : x1, hi ? x1 : x2, pos, hi, o);
    } else {
#pragma unroll
      for (int i = 0; i < 8; ++i) o[i] = hi ? x2[i] : x1[i];
    }
    *(uint4*)((bf16_t*)(p.ws + OFF_KR) + (size_t)r * 32 + gsel * 16 + (hi ? 8 : 0)) = packf8(o);
  } else {
    const float* gt = (const float*)(p.ws + OFF_GATES) + (size_t)r * 32;
    float* dt = (float*)(p.ws + OFF_DT) + (size_t)r * 16;
    float* da = (float*)(p.ws + OFF_DA) + (size_t)r * 16;
#pragma unroll
    for (int i = 0; i < 4; ++i) {
      int idx = (sub - 4) * 4 + i;
      float d = softplusf(gt[idx] + p.ev_dt_bias[e * 16 + idx]);
      dt[idx] = d;
      da[idx] = -d * __expf(p.ev_a_log[e * 16 + idx]);
    }
  }
}

__device__ void conv_phase(const Params& p, int layer, bool even, char* smem) {
  const int ntt = R / 64;
  const int G = gridDim.x, bi = bidx();
  const bool fast = (G & 7) == 0;
  const int sub = tidx() & 7, li = layer >> 1;
  const float* cw = even ? p.ev_conv_w + li * 5 * 1024 : p.od_conv_w + li * 5 * 1024;
  const float* cb = even ? p.ev_conv_b + li * 1024 : p.od_conv_b + li * 1024;
  float wreg[5][16], breg[16];
  int cg_cur = -1;
  const int nit = fast ? ((ntt - (bi >> 3) + (G >> 3) - 1) / (G >> 3)) : ((ntt * 8 - bi + G - 1) / G);
  for (int it = 0; it < nit; ++it) {
    int cgp, tt;
    if (fast) { cgp = bi & 7; tt = (bi >> 3) + it * (G >> 3); }
    else { const int t = bi + it * G; cgp = t / ntt; tt = t - cgp * ntt; }
    if (cgp != cg_cur) {
      cg_cur = cgp;
      const int ch0 = cgp * 128 + sub * 16;
#pragma unroll
      for (int q = 0; q < 4; ++q) {
        float4 t4 = *(const float4*)(cb + ch0 + q * 4);
        breg[q * 4] = t4.x; breg[q * 4 + 1] = t4.y; breg[q * 4 + 2] = t4.z; breg[q * 4 + 3] = t4.w;
#pragma unroll
        for (int j = 0; j < 5; ++j) {
          float4 w4 = *(const float4*)(cw + j * 1024 + ch0 + q * 4);
          wreg[j][q * 4] = w4.x; wreg[j][q * 4 + 1] = w4.y; wreg[j][q * 4 + 2] = w4.z; wreg[j][q * 4 + 3] = w4.w;
        }
      }
    }
    conv_tile(p, layer, even, tt, cgp, smem, wreg, breg);
  }
  if (even) for (int t = bi; t < ntt; t += G) misc_tile(p, layer, t);
}

__device__ void attn_tile(const Params& p, int b, int hh, int qt, char* smem) {
  bf16_t* Ks = (bf16_t*)smem;
  bf16_t* Vs = Ks + 2 * 64 * 104;
  const int tid = tidx(), lane = tid & 63, wave = __builtin_amdgcn_readfirstlane(tid >> 6), l15 = lane & 15, quad = lane >> 4;
  const bf16_t* Qg = (const bf16_t*)(p.ws + OFF_Q);
  const bf16_t* KNg = (const bf16_t*)(p.ws + OFF_KN);
  const bf16_t* KRg = (const bf16_t*)(p.ws + OFF_KR);
  const bf16_t* VTg = (const bf16_t*)(p.ws + OFF_VTE);
  const bool is_ctx = (qt == 8);
  const int kbeg = is_ctx ? 2048 : 0;
  const int nkt = (LB - kbeg) / 64;
  bf16x8 qf[2][3];
#pragma unroll
  for (int qi = 0; qi < 2; ++qi) {
    const int sq = qt * 256 + wave * 32 + qi * 16 + l15;
    const bf16_t* qp = Qg + (size_t)(b * LB + sq) * 768 + hh * 96;
#pragma unroll
    for (int ks = 0; ks < 3; ++ks) qf[qi][ks] = *(const bf16x8*)(qp + ks * 32 + quad * 8);
    if (!is_ctx) {
      float own[8], par[8], o[8];
      unpack8(*(const uint4*)(qp + 64 + quad * 8), own);
      unpack8(*(const uint4*)(qp + 64 + (quad ^ 1) * 8), par);
      float pos = (float)((quad < 2) ? (sq >> 6) : (sq & 63));
      rope8(own, par, pos, (quad & 1) != 0, o);
      union { uint4 u; bf16x8 v; } cv; cv.u = packf8(o);
      qf[qi][2] = cv.v;
    }
  }
  f32x4 o[4][2];
#pragma unroll
  for (int i = 0; i < 4; ++i)
#pragma unroll
    for (int j = 0; j < 2; ++j) o[i][j] = (f32x4){0.f, 0.f, 0.f, 0.f};
  float mrun[2] = {-1e30f, -1e30f}, lrun[2] = {0.f, 0.f};
  uint4 rk0, rk1, rv;
  const int kr0 = tid >> 3, kc0 = (tid & 7) * 8;
  const int kr1 = tid >> 2, kc1 = (tid & 3) * 8;
#define ALOAD(kt) do { \
    const size_t rowb_ = (size_t)b * LB + kbeg + (kt) * 64; \
    rk0 = *(const uint4*)(KNg + (rowb_ + kr0) * 512 + hh * 64 + kc0); \
    if (tid < 256) rk1 = *(const uint4*)(KRg + (rowb_ + kr1) * 32 + kc1); \
    rv = *(const uint4*)(VTg + ((size_t)(b * 512 + hh * 64 + kr0)) * LB + kbeg + (kt) * 64 + kc0); } while (0)
#define ASTORE(buf) do { \
    *(uint4*)(Ks + ((buf) * 64 + kr0) * 104 + kc0) = rk0; \
    if (tid < 256) *(uint4*)(Ks + ((buf) * 64 + kr1) * 104 + 64 + kc1) = rk1; \
    *(uint4*)(Vs + ((buf) * 64 + kr0) * 72 + kc0) = rv; } while (0)
  __syncthreads();
  ALOAD(0); ASTORE(0);
  __syncthreads();
  const float SCALE = 0.10206207261596577f * 1.4426950408889634f;
#pragma unroll 1
  for (int kt = 0; kt < nkt; ++kt) {
    const int buf = kt & 1;
    if (kt + 1 < nkt) ALOAD(kt + 1);
    f32x4 sacc[4][2];
#pragma unroll
    for (int i = 0; i < 4; ++i)
#pragma unroll
      for (int j = 0; j < 2; ++j) sacc[i][j] = (f32x4){0.f, 0.f, 0.f, 0.f};
#pragma unroll
    for (int ks = 0; ks < 3; ++ks) {
#pragma unroll
      for (int kti = 0; kti < 4; ++kti) {
        bf16x8 kf = *(const bf16x8*)(Ks + (buf * 64 + kti * 16 + l15) * 104 + ks * 32 + quad * 8);
#pragma unroll
        for (int qi = 0; qi < 2; ++qi) sacc[kti][qi] = mfma16(kf, qf[qi][ks], sacc[kti][qi]);
      }
    }
#pragma unroll
    for (int qi = 0; qi < 2; ++qi) {
      float mx = -1e30f;
#pragma unroll
      for (int kti = 0; kti < 4; ++kti)
#pragma unroll
        for (int e = 0; e < 4; ++e) mx = fmaxf(mx, sacc[kti][qi][e]);
      mx = fmaxf(mx, __shfl_xor(mx, 16)); mx = fmaxf(mx, __shfl_xor(mx, 32));
      float mnew = fmaxf(mrun[qi], mx * SCALE);
      float alpha = __builtin_amdgcn_exp2f(mrun[qi] - mnew);
      mrun[qi] = mnew;
      float ls = 0.f;
#pragma unroll
      for (int kti = 0; kti < 4; ++kti)
#pragma unroll
        for (int e = 0; e < 4; ++e) { float pv = __builtin_amdgcn_exp2f(fmaf(sacc[kti][qi][e], SCALE, -mnew)); sacc[kti][qi][e] = pv; ls += pv; }
      lrun[qi] = lrun[qi] * alpha + ls;
#pragma unroll
      for (int dvt = 0; dvt < 4; ++dvt) o[dvt][qi] *= alpha;
    }
#pragma unroll
    for (int kp = 0; kp < 2; ++kp) {
      bf16x8 pf[2];
#pragma unroll
      for (int qi = 0; qi < 2; ++qi) pf[qi] = pack8(sacc[2 * kp][qi], sacc[2 * kp + 1][qi]);
#pragma unroll
      for (int dvt = 0; dvt < 4; ++dvt) {
        const bf16_t* vp = Vs + (buf * 64 + dvt * 16 + l15) * 72 + quad * 4;
        bf16x8 vf = cat44(*(const uint2*)(vp + (2 * kp) * 16), *(const uint2*)(vp + (2 * kp + 1) * 16));
#pragma unroll
        for (int qi = 0; qi < 2; ++qi) o[dvt][qi] = mfma16(vf, pf[qi], o[dvt][qi]);
      }
    }
    if (kt + 1 < nkt) ASTORE(buf ^ 1);
    __syncthreads();
  }
#undef ALOAD
#undef ASTORE
  bf16_t* cat = (bf16_t*)((char*)p.out);
#pragma unroll
  for (int qi = 0; qi < 2; ++qi) {
    float l = lrun[qi];
    l += __shfl_xor(l, 16); l += __shfl_xor(l, 32);
    float inv = __builtin_amdgcn_rcpf(l);
    const int sq = qt * 256 + wave * 32 + qi * 16 + l15;
#pragma unroll
    for (int dvt = 0; dvt < 4; ++dvt) {
      f32x4 v = o[dvt][qi] * inv;
      *(uint2*)(cat + (size_t)(b * LB + sq) * DM + hh * 64 + dvt * 16 + quad * 4) = pack4(v);
    }
  }
}

__device__ void ssd_tile(const Params& p, int e, int b, int d, int hh, char* smem) {
  bf16_t* Cm = (bf16_t*)smem;
  bf16_t* Bm = Cm + 128 * 136;
  bf16_t* BmT = Bm + 128 * 136;
  bf16_t* XT = BmT + 128 * 136;
  bf16_t* Hs = XT + 64 * 136;
  float* acum = (float*)(Hs + 64 * 136);
  float* toend = acum + 128;
  float* dts = toend + 128;
  float* scal = dts + 128;
  const int tid = tidx(), lane = tid & 63, wave = __builtin_amdgcn_readfirstlane(tid >> 6), l15 = lane & 15, quad = lane >> 4;
  const int g = hh >> 2;
  const float Dk = p.ev_d_skip[e * 8 + hh];
  const bf16_t* CMg = (const bf16_t*)(p.ws + OFF_CM);
  const bf16_t* BMg = (const bf16_t*)(p.ws + OFF_BM);
  const bf16_t* BMTg = (const bf16_t*)(p.ws + OFF_BMT);
  const bf16_t* XTg = (const bf16_t*)(p.ws + OFF_XT);
  const float* DTg = (const float*)(p.ws + OFF_DT);
  const float* DAg = (const float*)(p.ws + OFF_DA);
  bf16_t* Yg = (bf16_t*)(p.ws + OFF_Y) + (size_t)d * R * 512;
  f32x4 hst[4];
#pragma unroll
  for (int i = 0; i < 4; ++i) hst[i] = (f32x4){0.f, 0.f, 0.f, 0.f};
  __syncthreads();
  for (int idx = tid; idx < 64 * 136 / 8; idx += NT) *(uint4*)(Hs + idx * 8) = make_uint4(0, 0, 0, 0);
  const int tcol = wave * 16 + l15;
#pragma unroll 1
  for (int step = 0; step < 18; ++step) {
    const int chunk = d ? (17 - step) : (step < 2 ? 16 + step : step - 2);
    const int row0 = b * LB + chunk * 128, pos0 = chunk * 128;
    __syncthreads();
    if (wave == 0) {
      const int i0 = d ? 127 - 2 * lane : 2 * lane, i1 = d ? 126 - 2 * lane : 2 * lane + 1;
      float a0 = DAg[(size_t)(row0 + i0) * 16 + d * 8 + hh], a1 = DAg[(size_t)(row0 + i1) * 16 + d * 8 + hh];
      float t0 = DTg[(size_t)(row0 + i0) * 16 + d * 8 + hh], t1 = DTg[(size_t)(row0 + i1) * 16 + d * 8 + hh];
      float loc = a0 + a1;
      float incl = scan_add(loc, lane);
      float excl = incl - loc;
      float c0 = excl + a0, c1 = excl + loc;
      float total = __shfl(incl, 63);
      acum[i0] = c0; acum[i1] = c1;
      toend[i0] = __expf(total - c0) * t0; toend[i1] = __expf(total - c1) * t1;
      dts[i0] = t0; dts[i1] = t1;
      if (lane == 0) scal[0] = total;
    }
    uint4 rbt[4];
#pragma unroll
    for (int i = 0; i < 4; ++i) {
      int idx = tid + i * NT; int rr = idx >> 4, cc = (idx & 15) * 8;
      *(uint4*)(Cm + rr * 136 + cc) = *(const uint4*)(CMg + (size_t)(row0 + rr) * 256 + g * 128 + cc);
      *(uint4*)(Bm + rr * 136 + cc) = *(const uint4*)(BMg + (size_t)(row0 + rr) * 256 + g * 128 + cc);
      rbt[i] = *(const uint4*)(BMTg + ((size_t)(b * 256 + g * 128 + rr)) * LB + pos0 + cc);
    }
#pragma unroll
    for (int i = 0; i < 2; ++i) {
      int idx = tid + i * NT; int rr = idx >> 4, cc = (idx & 15) * 8;
      *(uint4*)(XT + rr * 136 + cc) = *(const uint4*)(XTg + ((size_t)(b * 512 + hh * 64 + rr)) * LB + pos0 + cc);
    }
    __syncthreads();
#pragma unroll
    for (int i = 0; i < 4; ++i) {
      int idx = tid + i * NT; int rr = idx >> 4, cc = (idx & 15) * 8;
      float f[8]; unpack8(rbt[i], f);
#pragma unroll
      for (int q = 0; q < 8; ++q) f[q] *= toend[cc + q];
      *(uint4*)(BmT + rr * 136 + cc) = packf8(f);
    }
    const float total = scal[0];
    const float act = acum[tcol];
    bf16x8 cfr[4];
#pragma unroll
    for (int ks = 0; ks < 4; ++ks) cfr[ks] = *(const bf16x8*)(Cm + tcol * 136 + ks * 32 + quad * 8);
    f32x4 y[4];
#pragma unroll
    for (int i = 0; i < 4; ++i) y[i] = (f32x4){0.f, 0.f, 0.f, 0.f};
#pragma unroll
    for (int ks = 0; ks < 4; ++ks)
#pragma unroll
      for (int pt = 0; pt < 4; ++pt) {
        bf16x8 af = *(const bf16x8*)(Hs + (pt * 16 + l15) * 136 + ks * 32 + quad * 8);
        y[pt] = mfma16(af, cfr[ks], y[pt]);
      }
    {
      float et = __expf(act);
#pragma unroll
      for (int pt = 0; pt < 4; ++pt) y[pt] *= et;
    }
    f32x4 w[8];
#pragma unroll
    for (int i = 0; i < 8; ++i) w[i] = (f32x4){0.f, 0.f, 0.f, 0.f};
#pragma unroll
    for (int ks = 0; ks < 4; ++ks)
#pragma unroll
      for (int st = 0; st < 8; ++st) {
        bf16x8 af = *(const bf16x8*)(Bm + (st * 16 + l15) * 136 + ks * 32 + quad * 8);
        w[st] = mfma16(af, cfr[ks], w[st]);
      }
#pragma unroll
    for (int st = 0; st < 8; ++st)
#pragma unroll
      for (int jj = 0; jj < 4; ++jj) {
        int s = st * 16 + quad * 4 + jj;
        bool valid = d ? (s >= tcol) : (s <= tcol);
        float dec = valid ? __expf(act - acum[s]) * dts[s] : 0.f;
        w[st][jj] = valid ? w[st][jj] * dec : 0.f;
      }
#pragma unroll
    for (int kp = 0; kp < 4; ++kp) {
      bf16x8 pf = pack8(w[2 * kp], w[2 * kp + 1]);
#pragma unroll
      for (int pt = 0; pt < 4; ++pt) {
        const bf16_t* vp = XT + (pt * 16 + l15) * 136 + quad * 4;
        bf16x8 vf = cat44(*(const uint2*)(vp + (2 * kp) * 16), *(const uint2*)(vp + (2 * kp + 1) * 16));
        y[pt] = mfma16(vf, pf, y[pt]);
      }
    }
    if (d == 0) {
#pragma unroll
      for (int pt = 0; pt < 4; ++pt)
#pragma unroll
        for (int jj = 0; jj < 4; ++jj) y[pt][jj] += Dk * bf2f(XT[(pt * 16 + quad * 4 + jj) * 136 + tcol]);
    }
#pragma unroll
    for (int pt = 0; pt < 4; ++pt)
      *(uint2*)(Yg + (size_t)(row0 + tcol) * 512 + hh * 64 + pt * 16 + quad * 4) = pack4(y[pt]);
    __syncthreads();
    {
      float edec = __expf(total);
#pragma unroll
      for (int pt = 0; pt < 4; ++pt) hst[pt] *= edec;
#pragma unroll
      for (int ks = 0; ks < 4; ++ks) {
        bf16x8 af = *(const bf16x8*)(BmT + (wave * 16 + l15) * 136 + ks * 32 + quad * 8);
#pragma unroll
        for (int pt = 0; pt < 4; ++pt) {
          bf16x8 bfv = *(const bf16x8*)(XT + (pt * 16 + l15) * 136 + ks * 32 + quad * 8);
          hst[pt] = mfma16(af, bfv, hst[pt]);
        }
      }
#pragma unroll
      for (int pt = 0; pt < 4; ++pt) *(uint2*)(Hs + (pt * 16 + l15) * 136 + wave * 16 + quad * 4) = pack4(hst[pt]);
    }
  }
  __syncthreads();
}

__device__ void mlstm_tile(const Params& p, int o_, int b, int d, int hh, int vh, char* smem) {
  bf16_t* Qs = (bf16_t*)smem;
  bf16_t* Ks = Qs + 128 * 72;
  bf16_t* KTs = Ks + 128 * 72;
  bf16_t* VT = KTs + 64 * 136;
  bf16_t* Cs = VT + 80 * 136;
  float* bb = (float*)(Cs + 80 * 72);
  float* icb = bb + 128;
  float* mts = icb + 128;
  float* wts = mts + 128;
  float* scal = wts + 128;
  const int tid = tidx(), lane = tid & 63, wave = __builtin_amdgcn_readfirstlane(tid >> 6), l15 = lane & 15, quad = lane >> 4;
  const float ib = p.od_i_bias[o_ * 16 + d * 8 + hh], fb = p.od_f_bias[o_ * 16 + d * 8 + hh];
  const bf16_t* QCg = (const bf16_t*)(p.ws + OFF_QC);
  const bf16_t* KCg = (const bf16_t*)(p.ws + OFF_KC);
  const bf16_t* KTg = (const bf16_t*)(p.ws + OFF_KT);
  const bf16_t* VTg = (const bf16_t*)(p.ws + OFF_VTO);
  const float* Gg = (const float*)(p.ws + OFF_GATES);
  bf16_t* Hg = (bf16_t*)(p.ws + OFF_HB) + (size_t)d * R * 1024;
  __syncthreads();
  for (int idx = tid; idx < 80 * 72 / 8; idx += NT) *(uint4*)(Cs + idx * 8) = make_uint4(0, 0, 0, 0);
  for (int idx = tid; idx < 16 * 136 / 8; idx += NT) {
    unsigned v = (idx < 136 / 8) ? 0x3F803F80u : 0u;
    *(uint4*)(VT + 64 * 136 + idx * 8) = make_uint4(v, v, v, v);
  }
  const int dkt = wave & 3, vbase = (wave >> 2) * 2;
  f32x4 cst[3];
#pragma unroll
  for (int i = 0; i < 3; ++i) cst[i] = (f32x4){0.f, 0.f, 0.f, 0.f};
  float m_in = 0.f;
  const int tcol = wave * 16 + l15;
  uint4 pq0, pq1, pk0, pk1, pv0, pv1, rkt0, rkt1;
  float pf0 = 0.f, pf1 = 0.f, pg0 = 0.f, pg1 = 0.f;
#define ML_FETCH1(i_, row0n_, pos0n_) do { const int idx_ = tid + (i_) * NT; const int rr_ = idx_ >> 3, cc_ = (idx_ & 7) * 8, r2_ = idx_ >> 4, c2_ = (idx_ & 15) * 8; \
      pq##i_ = *(const uint4*)(QCg + (size_t)((row0n_) + rr_) * 512 + hh * 64 + cc_); \
      pk##i_ = *(const uint4*)(KCg + (size_t)((row0n_) + rr_) * 512 + hh * 64 + cc_); \
      rkt##i_ = *(const uint4*)(KTg + ((size_t)(b * 512 + hh * 64 + r2_)) * LB + (pos0n_) + c2_); \
      pv##i_ = *(const uint4*)(VTg + ((size_t)(b * 1024 + hh * 128 + vh * 64 + r2_)) * LB + (pos0n_) + c2_); } while (0)
#define ML_FETCH(chunk_) do { const int row0n_ = b * LB + (chunk_) * 128, pos0n_ = (chunk_) * 128; \
    ML_FETCH1(0, row0n_, pos0n_); ML_FETCH1(1, row0n_, pos0n_); \
    if (wave == 0) { const int i0_ = d ? 127 - 2 * lane : 2 * lane, i1_ = d ? 126 - 2 * lane : 2 * lane + 1; \
      pf0 = Gg[(size_t)(row0n_ + i0_) * 32 + 16 + d * 8 + hh]; pf1 = Gg[(size_t)(row0n_ + i1_) * 32 + 16 + d * 8 + hh]; \
      pg0 = Gg[(size_t)(row0n_ + i0_) * 32 + d * 8 + hh]; pg1 = Gg[(size_t)(row0n_ + i1_) * 32 + d * 8 + hh]; } } while (0)
  ML_FETCH(d ? 17 : 16);
#pragma unroll 1
  for (int step = 0; step < 18; ++step) {
    const int chunk = d ? (17 - step) : (step < 2 ? 16 + step : step - 2);
    const int row0 = b * LB + chunk * 128, pos0 = chunk * 128;
    __syncthreads();
    if (wave == 0) {
      const int i0 = d ? 127 - 2 * lane : 2 * lane, i1 = d ? 126 - 2 * lane : 2 * lane + 1;
      const float f0 = pf0 + fb, f1 = pf1 + fb, g0 = pg0 + ib, g1 = pg1 + ib;
      float lf0 = -softplusf(-f0), lf1 = -softplusf(-f1);
      float loc = lf0 + lf1;
      float incl = scan_add(loc, lane);
      float excl = incl - loc;
      float b0 = excl + lf0, b1 = excl + loc;
      float blast = __shfl(incl, 63);
      float c0 = g0 - b0, c1 = g1 - b1;
      float lm = fmaxf(c0, c1);
      float pmi = scan_max(lm, lane);
      float pme = __shfl_up(pmi, 1); if (lane == 0) pme = -1e30f;
      float pm0 = fmaxf(pme, c0), pm1 = pmi;
      float mt0 = b0 + fmaxf(m_in, pm0), mt1 = b1 + fmaxf(m_in, pm1);
      float mw = blast + __shfl(pmi, 63);
      float m_new = fmaxf(blast + m_in, mw);
      float keepS = __expf(blast + m_in - m_new);
      bb[i0] = b0; bb[i1] = b1; icb[i0] = c0; icb[i1] = c1; mts[i0] = mt0; mts[i1] = mt1;
      wts[i0] = __expf(blast + c0 - m_new); wts[i1] = __expf(blast + c1 - m_new);
      if (lane == 0) { scal[0] = m_new; scal[1] = keepS; }
    }
    uint4 ckt0, ckt1;
    {
      int idx = tid; int rr = idx >> 3, cc = (idx & 7) * 8, r2 = idx >> 4, c2 = (idx & 15) * 8;
      *(uint4*)(Qs + rr * 72 + cc) = pq0; *(uint4*)(Ks + rr * 72 + cc) = pk0; *(uint4*)(VT + r2 * 136 + c2) = pv0; ckt0 = rkt0;
      idx = tid + NT; rr = idx >> 3; cc = (idx & 7) * 8; r2 = idx >> 4; c2 = (idx & 15) * 8;
      *(uint4*)(Qs + rr * 72 + cc) = pq1; *(uint4*)(Ks + rr * 72 + cc) = pk1; *(uint4*)(VT + r2 * 136 + c2) = pv1; ckt1 = rkt1;
    }
    if (step + 1 < 18) { const int nchunk = d ? (16 - step) : (step + 1 < 2 ? 17 : step - 1); ML_FETCH(nchunk); }
    __syncthreads();
    {
      int idx = tid; int r2 = idx >> 4, c2 = (idx & 15) * 8;
      float f[8]; unpack8(ckt0, f);
#pragma unroll
      for (int q = 0; q < 8; ++q) f[q] *= wts[c2 + q];
      *(uint4*)(KTs + r2 * 136 + c2) = packf8(f);
      idx = tid + NT; r2 = idx >> 4; c2 = (idx & 15) * 8;
      unpack8(ckt1, f);
#pragma unroll
      for (int q = 0; q < 8; ++q) f[q] *= wts[c2 + q];
      *(uint4*)(KTs + r2 * 136 + c2) = packf8(f);
    }
    const float m_new = scal[0], keepS = scal[1];
    const float bt = bb[tcol], mtt = mts[tcol];
    bf16x8 qfr[2];
#pragma unroll
    for (int ks = 0; ks < 2; ++ks) qfr[ks] = *(const bf16x8*)(Qs + tcol * 72 + ks * 32 + quad * 8);
    f32x4 a[8];
#pragma unroll
    for (int i = 0; i < 8; ++i) a[i] = (f32x4){0.f, 0.f, 0.f, 0.f};
#pragma unroll
    for (int ks = 0; ks < 2; ++ks)
#pragma unroll
      for (int st = 0; st < 8; ++st) {
        bf16x8 af = *(const bf16x8*)(Ks + (st * 16 + l15) * 72 + ks * 32 + quad * 8);
        a[st] = mfma16(af, qfr[ks], a[st]);
      }
#pragma unroll
    for (int st = 0; st < 8; ++st)
#pragma unroll
      for (int jj = 0; jj < 4; ++jj) {
        int s = st * 16 + quad * 4 + jj;
        bool valid = d ? (s >= tcol) : (s <= tcol);
        float dm = valid ? __expf(bt + icb[s] - mtt) : 0.f;
        a[st][jj] = valid ? a[st][jj] * dm : 0.f;
      }
    bf16x8 pfa[4];
#pragma unroll
    for (int kp = 0; kp < 4; ++kp) pfa[kp] = pack8(a[2 * kp], a[2 * kp + 1]);
    f32x4 nu[5];
#pragma unroll
    for (int i = 0; i < 5; ++i) nu[i] = (f32x4){0.f, 0.f, 0.f, 0.f};
#pragma unroll
    for (int ks = 0; ks < 2; ++ks)
#pragma unroll
      for (int vt = 0; vt < 5; ++vt) {
        bf16x8 af = *(const bf16x8*)(Cs + (vt * 16 + l15) * 72 + ks * 32 + quad * 8);
        nu[vt] = mfma16(af, qfr[ks], nu[vt]);
      }
    {
      float kt_ = __expf(bt + m_in - mtt);
#pragma unroll
      for (int vt = 0; vt < 5; ++vt) nu[vt] *= (DBG_NOSTATE ? 0.f : kt_);
    }
#pragma unroll
    for (int kp = 0; kp < 4; ++kp) {
      bf16x8 pf = pfa[kp];
#pragma unroll
      for (int vt = 0; vt < 5; ++vt) {
        const bf16_t* vp = VT + (vt * 16 + l15) * 136 + quad * 4;
        bf16x8 vf = cat44(*(const uint2*)(vp + (2 * kp) * 16), *(const uint2*)(vp + (2 * kp + 1) * 16));
        nu[vt] = mfma16(vf, pf, nu[vt]);
      }
    }
    {
      float den = __shfl(nu[4][0], l15);
      float dd = fmaxf(fabsf(den), __expf(-mtt));
      float inv = __builtin_amdgcn_rcpf(dd);
#pragma unroll
      for (int vt = 0; vt < 4; ++vt) {
        f32x4 v = nu[vt] * inv;
        *(uint2*)(Hg + (size_t)(row0 + tcol) * 1024 + hh * 128 + vh * 64 + vt * 16 + quad * 4) = pack4(v);
      }
    }
    __syncthreads();
#pragma unroll
    for (int k = 0; k < 3; ++k) cst[k] *= keepS;
#pragma unroll
    for (int ks = 0; ks < 4; ++ks) {
      bf16x8 af = *(const bf16x8*)(KTs + (dkt * 16 + l15) * 136 + ks * 32 + quad * 8);
#pragma unroll
      for (int k = 0; k < 3; ++k) {
        {
          const int vt_ = (k < 2) ? (vbase + k) : 4;
          bf16x8 bfv = *(const bf16x8*)(VT + (vt_ * 16 + l15) * 136 + ks * 32 + quad * 8);
          cst[k] = mfma16(af, bfv, cst[k]);
        }
      }
    }
#pragma unroll
    for (int k = 0; k < 3; ++k)
      { const int vt_ = (k < 2) ? (vbase + k) : 4; *(uint2*)(Cs + (vt_ * 16 + l15) * 72 + dkt * 16 + quad * 4) = pack4(cst[k]); }
    m_in = m_new;
  }
#undef ML_FETCH
#undef ML_FETCH1
  __syncthreads();
}

__device__ void gnorm_phase(const Params& p, int layer) {
  const int lane = tidx() & 63, wave = __builtin_amdgcn_readfirstlane(tidx() >> 6);
  const int e = layer >> 1;
  const bf16_t* Y0 = (const bf16_t*)(p.ws + OFF_Y);
  const bf16_t* Y1 = Y0 + (size_t)R * 512;
  const bf16_t* U = (const bf16_t*)(p.ws + OFF_UE);
  bf16_t* cat = (bf16_t*)((char*)p.out);
  for (int r = bidx() * 8 + wave; r < R; r += gridDim.x * 8) {
    const int c0 = lane * 8;
    float y0[8], y1[8], z[8];
    unpack8(*(const uint4*)(Y0 + (size_t)r * 512 + c0), y0);
    unpack8(*(const uint4*)(Y1 + (size_t)r * 512 + c0), y1);
    unpack8(*(const uint4*)(U + (size_t)r * 2304 + 544 + c0), z);
    float gv[8]; float ss = 0.f;
#pragma unroll
    for (int i = 0; i < 8; ++i) { gv[i] = (y0[i] + y1[i]) * siluf(z[i]); ss += gv[i] * gv[i]; }
#pragma unroll
    for (int o = 16; o > 0; o >>= 1) ss += __shfl_xor(ss, o);
    float rstd = rsqrtf(ss * (1.f / 256.f) + EPS);
    const float* nw = p.ev_ssm_norm_w + e * 512 + c0;
#pragma unroll
    for (int i = 0; i < 8; ++i) gv[i] = gv[i] * rstd * nw[i];
    *(uint4*)(cat + (size_t)r * DM + 512 + c0) = packf8(gv);
  }
}

__device__ void finish_phase(const Params& p, int layer) {
  const int lane = tidx() & 63, wave = __builtin_amdgcn_readfirstlane(tidx() >> 6);
  const int o_ = layer >> 1;
  const bf16_t* H0 = (const bf16_t*)(p.ws + OFF_HB);
  const bf16_t* H1 = H0 + (size_t)R * 1024;
  const bf16_t* U = (const bf16_t*)(p.ws + OFF_UO);
  bf16_t* cat = (bf16_t*)((char*)p.out);
  for (int r = bidx() * 8 + wave; r < R; r += gridDim.x * 8) {
    const int c0 = lane * 16;
    float h[16], t[16], og[16];
    unpack8(*(const uint4*)(H0 + (size_t)r * 1024 + c0), h); unpack8(*(const uint4*)(H0 + (size_t)r * 1024 + c0 + 8), h + 8);
    unpack8(*(const uint4*)(H1 + (size_t)r * 1024 + c0), t); unpack8(*(const uint4*)(H1 + (size_t)r * 1024 + c0 + 8), t + 8);
    unpack8(*(const uint4*)(U + (size_t)r * 2048 + 1024 + c0), og); unpack8(*(const uint4*)(U + (size_t)r * 2048 + 1024 + c0 + 8), og + 8);
    float ss = 0.f;
#pragma unroll
    for (int i = 0; i < 16; ++i) { h[i] += t[i]; ss += h[i] * h[i]; }
    ss += __shfl_xor(ss, 1); ss += __shfl_xor(ss, 2); ss += __shfl_xor(ss, 4);
    float rstd = rsqrtf(ss * (1.f / 128.f) + EPS);
    const float* nw = p.od_head_norm_w + o_ * 1024 + c0;
#pragma unroll
    for (int i = 0; i < 16; ++i) h[i] = sigmoidf(og[i]) * h[i] * rstd * nw[i];
    *(uint4*)(cat + (size_t)r * DM + c0) = packf8(h);
    *(uint4*)(cat + (size_t)r * DM + c0 + 8) = packf8(h + 8);
  }
}


#define XB_TMO      128
#define XB_XCNT(j)  (256  + 64 * (j))
#define XB_XSUB(j)  (1280 + 64 * (j))
#define XB_XGEN(j)  (2304 + 64 * (j))
#define XB_TOP      3328
#define XB_TOPGEN   3392
#define XCD_BAR_WORDS 3456
#define XB_SPIN_CAP (1u << 20)
#define LAS __attribute__((address_space(3)))
__device__ __forceinline__ unsigned xb_ld(unsigned* p)              { return __hip_atomic_load(p, __ATOMIC_RELAXED, __HIP_MEMORY_SCOPE_AGENT); }
__device__ __forceinline__ unsigned xb_add(unsigned* p, unsigned v) { return __hip_atomic_fetch_add(p, v, __ATOMIC_RELAXED, __HIP_MEMORY_SCOPE_AGENT); }
__device__ __forceinline__ unsigned xb_xcc_id() { return (unsigned)__builtin_amdgcn_s_getreg((3 << 11) | 20) & 0xFu; }
#define XB_SPIN(cond, bar) do { unsigned _sp = 0; while (cond) { __builtin_amdgcn_s_sleep(1); \
    if ((++_sp & 255u) == 0u) { if (xb_ld(&(bar)[XB_TMO])) break; if (_sp > XB_SPIN_CAP) { atomicAdd(&(bar)[XB_TMO], 1u); break; } } } } while (0)
struct XcdBarrier { unsigned* bar; unsigned x; volatile LAS unsigned* st; };
__device__ __forceinline__ XcdBarrier xcd_barrier_post(unsigned* bar, volatile LAS unsigned* st) {
  XcdBarrier b; b.bar = bar; b.x = xb_xcc_id(); b.st = st;
  if (threadIdx.x == 0) (void)xb_add(&bar[XB_XCNT(b.x)], 1u);
  return b;
}
__device__ __forceinline__ void xcd_barrier_complete(unsigned* bar, unsigned x, unsigned& nloc, unsigned& nx) {
  const unsigned G = gridDim.x * gridDim.y * gridDim.z;
  unsigned sum, cnt, mine, sp = 0u;
  for (;;) {
    sum = 0u; cnt = 0u; mine = 0u;
#pragma unroll
    for (unsigned j = 0; j < 16; ++j) { const unsigned c = xb_ld(&bar[XB_XCNT(j)]); sum += c; cnt += (c > 0u) ? 1u : 0u; mine = (j == x) ? c : mine; }
    if (sum == G) break;
    __builtin_amdgcn_s_sleep(1);
    if ((++sp & 255u) == 0u) { if (xb_ld(&bar[XB_TMO])) break; if (sp > XB_SPIN_CAP) { atomicAdd(&bar[XB_TMO], 1u); break; } }
  }
  nloc = mine > 0u ? mine : 1u; nx = cnt > 0u ? cnt : 1u;
}
__device__ __forceinline__ void xcd_barrier(const XcdBarrier& b) {
  asm volatile("s_waitcnt vmcnt(0)" ::: "memory");
  __syncthreads();
  if (threadIdx.x == 0) {
    unsigned* bar = b.bar;
    __builtin_amdgcn_s_waitcnt(0);
    unsigned nloc = b.st[0], nx = b.st[1];
    if (nloc == 0u) { xcd_barrier_complete(bar, b.x, nloc, nx); b.st[0] = nloc; b.st[1] = nx; }
    const unsigned old = xb_add(&bar[XB_XSUB(b.x)], 1u);
    const unsigned gen = old / nloc;
    if (old + 1u == (gen + 1u) * nloc) {
      __builtin_amdgcn_fence(__ATOMIC_RELEASE, "agent");
      asm volatile("s_waitcnt vmcnt(0)" ::: "memory");
      const unsigned og = xb_add(&bar[XB_TOP], 1u);
      const unsigned tg = og / nx;
      if (og + 1u == (tg + 1u) * nx) xb_add(&bar[XB_TOPGEN], 1u);
      else XB_SPIN(xb_ld(&bar[XB_TOPGEN]) == tg, bar);
      __builtin_amdgcn_fence(__ATOMIC_ACQUIRE, "agent");
      xb_add(&bar[XB_XGEN(b.x)], 1u);
      asm volatile("s_waitcnt vmcnt(0)" ::: "memory");
    } else {
      XB_SPIN(xb_ld(&bar[XB_XGEN(b.x)]) == gen, bar);
      __builtin_amdgcn_fence(__ATOMIC_ACQUIRE, "agent");
      asm volatile("s_waitcnt vmcnt(0)" ::: "memory");
    }
  }
  __syncthreads();
}

__device__ void run_phase(const Params& p, int ph, char* smem) {
  if (ph == 0) { if (PHMASK & (1u << 13)) setup_phase(p, smem); return; }
  if (ph == NPH - 1) { if (PHMASK & (1u << 14)) final_phase(p); return; }
  const int q = ph - 1;
  const int pair = q / 19, rem = q - pair * 19;
  const bool even = rem < 10;
  const int layer = pair * 2 + (even ? 0 : 1);
  int st = even ? rem : rem - 10;
  const bool last = (layer == 3);
  const int li = layer >> 1;
  if (!even && st >= 3) st += 1;
  GemmDesc g, g2;
  g.layer = layer; g.gate_off = 0; g.skip_ctx = 0; g.A = nullptr; g.W = nullptr; g.lda = 1024; g.K = 1024; g.ntn = 0; g.epi = 0;
  g2 = g;
  int ntn2 = 0;
  bool is_gemm = false;
  switch (st) {
    case 0: if (PHMASK & 1u) norm_phase(p, layer, 0, false); break;
    case 1:
      is_gemm = true;
      g.A = (const bf16_t*)((char*)p.out);
      if (even) { g.W = (const bf16_t*)(p.ws + OFF_EVIN + li * SZ_EVIN); g.ntn = 9; g.epi = EPI_U_EVEN; }
      else { g.W = (const bf16_t*)(p.ws + OFF_ODIN + li * SZ_ODIN); g.ntn = 13; g.epi = EPI_U_ODD; }
      break;
    case 2: if (PHMASK & 4u) conv_phase(p, layer, even, smem); break;
    case 3:
      is_gemm = true;
      g.lda = 2304; g.K = 256; g.A = (const bf16_t*)(p.ws + OFF_UE); g.W = (const bf16_t*)(p.ws + OFF_UQ + li * SZ_UQ); g.epi = EPI_Q; g.ntn = 3;
      g2 = g; g2.A = (const bf16_t*)(p.ws + OFF_UE) + 256; g2.W = (const bf16_t*)(p.ws + OFF_UKV + li * SZ_UKV); g2.epi = EPI_KV; ntn2 = 4;
      break;
    case 4:
      if (even) {
        const int G_ = gridDim.x, bi = bidx();
        const bool bal = (G_ == 256);
        const int nit = bal ? (bi < 64 ? 2 : (bi < 128 ? 1 : 4)) : ((704 - bi + G_ - 1) / G_);
        for (int it = 0; it < nit; ++it) {
          int kind, ta, tb, tc;
          if (bal) {
            if (bi < 128) { if (it == 0) { kind = 0; ta = bi >> 4; tb = (bi >> 3) & 1; tc = bi & 7; } else { kind = 1; ta = bi >> 3; tb = bi & 7; tc = 8; } }
            else { const int j = bi - 128, xcd = j & 7, slot = j >> 3; const int bh = it * 16 + 2 * xcd + (slot >> 3); kind = 1; ta = bh >> 3; tb = bh & 7; tc = slot & 7; }
          } else {
            const int t = bi + it * G_;
            if (t < 128) { kind = 0; ta = t >> 4; tb = (t >> 3) & 1; tc = t & 7; }
            else { const int u = t - 128, bh = u / 9; kind = 1; ta = bh >> 3; tb = bh & 7; tc = u % 9; }
          }
          if (kind == 0) { if (PHMASK & (1u << 11)) ssd_tile(p, li, ta, tb, tc, smem); }
          else { if (PHMASK & (1u << 12)) attn_tile(p, ta, tb, tc, smem); }
        }
      } else {
        if (PHMASK & (1u << 10)) for (int t = bidx(); t < 256; t += gridDim.x) { int b = t >> 5, d = (t >> 4) & 1, hh = (t >> 1) & 7, vh = t & 1; mlstm_tile(p, li, b, d, hh, vh, smem); }
      }
      break;
    case 5: if (PHMASK & 32u) { if (even) gnorm_phase(p, layer); else finish_phase(p, layer); } break;
    case 6:
      is_gemm = true;
      g.A = (const bf16_t*)((char*)p.out); g.ntn = 4; g.epi = EPI_RESID; g.gate_off = 2048; g.skip_ctx = last;
      g.W = (const bf16_t*)(p.ws + (even ? OFF_EVOUT : OFF_ODOUT) + li * SZ_OUT);
      break;
    case 7: if (PHMASK & 1u) norm_phase(p, layer, 1, last); break;
    case 8:
      is_gemm = true;
      g.A = (const bf16_t*)((char*)p.out); g.ntn = 16; g.epi = EPI_SQRELU; g.skip_ctx = last;
      g.W = (const bf16_t*)(p.ws + OFF_W1 + layer * SZ_W1);
      break;
    case 9:
      is_gemm = true;
      g.A = (const bf16_t*)(p.ws + OFF_S); g.lda = 4096; g.K = 4096; g.ntn = 4; g.epi = EPI_RESID; g.gate_off = 5120; g.skip_ctx = last;
      g.W = (const bf16_t*)(p.ws + OFF_W2 + layer * SZ_W2);
      break;
  }
  if ((PHMASK & 2u) && is_gemm) {
    const int ntn = g.ntn + ntn2;
    const int nrt = (g.epi == EPI_RESID) ? 9 : (((g.epi == EPI_SQRELU && !g.skip_ctx) || g.epi == EPI_U_ODD) ? 12 : 16);
    const int per_b = LB / (nrt * 16);
    const int Tm = R / (nrt * 16);
    const int total = Tm * ntn;
    const int nig = 8 * ntn;
    const int nxb = gridDim.x >> 3;
    const int bi = bidx();
    const int spos = (bi & 7) * nxb + (bi >> 3);
    auto advance = [&](int& t0_, int& mt_, int& nt_) -> bool {
      while (true) {
        const int sidx = t0_ + spos;
        t0_ += gridDim.x;
        if (sidx >= total) return false;
        const int gid = sidx / nig, rem = sidx - gid * nig;
        const int fm = gid * 8;
        const int gsz = (Tm - fm) < 8 ? (Tm - fm) : 8;
        mt_ = fm + rem % gsz; nt_ = rem / gsz;
        if (g.skip_ctx && (mt_ % per_b) == per_b - 1) continue;
        return true;
      }
    };
    int t0 = 0, mt = 0, nt = 0;
    bool have = advance(t0, mt, nt);
    bool first = true;
    while (have) {
      int t0n = t0, mtn = 0, ntn_ = 0;
      const bool hn = advance(t0n, mtn, ntn_);
      GemmDesc h = g;
      int ntl = nt;
      if (nt >= g.ntn) { h.A = g2.A; h.W = g2.W; h.epi = g2.epi; ntl = nt - g.ntn; }
      const bf16_t* An = (ntn_ >= g.ntn) ? g2.A : g.A;
      const bf16_t* Wn = (ntn_ >= g.ntn) ? g2.W : g.W;
      const int ntnl = (ntn_ >= g.ntn) ? ntn_ - g.ntn : ntn_;
      An += (size_t)(mtn * nrt * 16) * g.lda;
      Wn += (size_t)(ntnl * 256) * g.K;
      gemm_tile(p, h, mt, ntl, smem, nrt, An, Wn, hn, first);
      first = false; have = hn; t0 = t0n; mt = mtn; nt = ntn_;
    }
  }
}

__global__ void __launch_bounds__(NT) mega(Params p) {
  extern __shared__ __attribute__((aligned(1024))) char smem[];
  volatile LAS unsigned* st = (volatile LAS unsigned*)(smem + LDS_PHASE);
  if (threadIdx.x == 0) { st[0] = 0u; st[1] = 0u; }
  __syncthreads();
  XcdBarrier xb = xcd_barrier_post((unsigned*)(p.ws + OFF_BAR), st);
  for (int ph = p.ph_begin; ph < p.ph_end; ++ph) {
    run_phase(p, ph, smem);
    if (p.coop && ph + 1 < p.ph_end) {
      if (ph == 0) cg::this_grid().sync();
      else xcd_barrier(xb);
    }
  }
}

__global__ void __launch_bounds__(256) dump_bf16(const bf16_t* src, float* dst, size_t n) {
  for (size_t i = (size_t)blockIdx.x * 256 + threadIdx.x; i < n; i += (size_t)gridDim.x * 256) dst[i] = __uint_as_float(((unsigned)src[i]) << 16);
}
__global__ void __launch_bounds__(256) dump_f32(const float* src, float* dst, size_t n) {
  for (size_t i = (size_t)blockIdx.x * 256 + threadIdx.x; i < n; i += (size_t)gridDim.x * 256) dst[i] = src[i];
}

extern "C" void kernel_launch(void* const* d_in, const int* in_sizes, int n_in, void* d_out, int out_size, void* d_ws, size_t ws_size, hipStream_t stream) {
  (void)in_sizes; (void)n_in; (void)out_size;
  if (ws_size < WS_TOTAL) { fprintf(stderr, "workspace too small: %zu < %zu\n", ws_size, (size_t)WS_NEED); return; }
  Params p;
  memset(&p, 0, sizeof(p));
  const float** fp = (const float**)&p.x;
  for (int i = 0; i < 30; ++i) fp[i] = (const float*)d_in[i];
  p.out = (float*)d_out; p.ws = (char*)d_ws;
#ifdef DBG_MEMSET
  (void)hipMemsetAsync((char*)d_ws + DBG_MS_OFF, 0, DBG_MS_LEN, stream);
#endif
  static bool attr_set = false;
  if (!attr_set) { (void)hipFuncSetAttribute((const void*)mega, hipFuncAttributeMaxDynamicSharedMemorySize, LDS_BYTES); attr_set = true; }
#if SINGLE_LAUNCH
  static int grid_blocks = 0;
  if (!grid_blocks) {
    int dev = 0, cus = 0, per_cu = 0;
    hipGetDevice(&dev);
    hipDeviceGetAttribute(&cus, hipDeviceAttributeMultiprocessorCount, dev);
    hipOccupancyMaxActiveBlocksPerMultiprocessor(&per_cu, mega, NT, LDS_BYTES);
    if (per_cu > 1) per_cu = 1;
    grid_blocks = cus * per_cu;
  }
  (void)hipMemsetAsync((char*)d_ws + OFF_BAR, 0, 16384, stream);
  p.ph_begin = 0; p.ph_end = NPH; p.coop = 1;
  void* args[] = {&p};
  hipError_t e = hipLaunchCooperativeKernel((void*)mega, dim3(grid_blocks), dim3(NT), args, LDS_BYTES, stream);
  if (e != hipSuccess) fprintf(stderr, "cooperative launch failed: %s (grid %d)\n", hipGetErrorString(e), grid_blocks);
#else
  for (int ph = 0; ph < NPH; ++ph) {
    if (ph >= 1 && ph < NPH - 1) { int q_ = ph - 1; int pr_ = q_ / 19, rm_ = q_ % 19; int ly_ = pr_ * 2 + (rm_ < 10 ? 0 : 1); if (!((DBG_LAYERS >> ly_) & 1)) continue; }
#ifdef DBG_STOP_PH
    if (ph > DBG_STOP_PH) continue;
#endif
    p.ph_begin = ph; p.ph_end = ph + 1; p.coop = 0;
    hipLaunchKernelGGL(mega, dim3(256), dim3(NT), LDS_BYTES, stream, p);
  }
#ifdef DBG_STOP_PH
#if DBG_DUMP_F32
  hipLaunchKernelGGL(dump_f32, dim3(2048), dim3(256), 0, stream, (const float*)((char*)d_ws + DBG_DUMP_OFF), (float*)d_out, (size_t)DBG_DUMP_N);
#else
  hipLaunchKernelGGL(dump_bf16, dim3(2048), dim3(256), 0, stream, (const bf16_t*)((char*)d_ws + DBG_DUMP_OFF), (float*)d_out, (size_t)DBG_DUMP_N);
#endif
#endif
#endif
}
```

```cpp
#include <hip/hip_runtime.h>
#include <hip/hip_cooperative_groups.h>
#include <cstdio>
#include <cstdint>
#include <cstring>
namespace cg = cooperative_groups;

#ifndef PHMASK
#define PHMASK 0xFFFFu
#endif
#ifndef DBG_LAYERS
#define DBG_LAYERS 0xF
#endif
#define DBG_NOSTATE 0
#define DBG_DUMP_OFF OFF_HB
#define DBG_DUMP_N ((size_t)8*2048*1024)
#define DBG_DUMP_F32 0
#ifndef RESID_MI
#define RESID_MI 6
#endif
#ifndef SINGLE_LAUNCH
#define SINGLE_LAUNCH 1
#endif

typedef unsigned short bf16_t;
typedef short bf16x8 __attribute__((ext_vector_type(8)));
typedef short bf16x4 __attribute__((ext_vector_type(4)));
typedef float f32x4 __attribute__((ext_vector_type(4)));

constexpr int NT = 512;
constexpr int DM = 1024;
constexpr int NB = 8;
constexpr int LB = 2304;
constexpr int R = NB * LB;
constexpr int NPH = 40;
constexpr float EPS = 1e-6f;
constexpr int LDS_PHASE = 141312;
constexpr int LDS_BYTES = LDS_PHASE + 16;

constexpr size_t SZ_W1 = (size_t)4096 * 1024 * 2, SZ_W2 = SZ_W1;
constexpr size_t SZ_EVIN = (size_t)2304 * 1024 * 2, SZ_UQ = (size_t)768 * 256 * 2, SZ_UKV = (size_t)1024 * 256 * 2, SZ_OUT = (size_t)1024 * 1024 * 2;
constexpr size_t SZ_ODIN = (size_t)3328 * 1024 * 2;
constexpr size_t OFF_W1 = 0;
constexpr size_t OFF_W2 = OFF_W1 + 4 * SZ_W1;
constexpr size_t OFF_EVIN = OFF_W2 + 4 * SZ_W2;
constexpr size_t OFF_UQ = OFF_EVIN + 2 * SZ_EVIN;
constexpr size_t OFF_UKV = OFF_UQ + 2 * SZ_UQ;
constexpr size_t OFF_EVOUT = OFF_UKV + 2 * SZ_UKV;
constexpr size_t OFF_ODIN = OFF_EVOUT + 2 * SZ_OUT;
constexpr size_t OFF_ODOUT = OFF_ODIN + 2 * SZ_ODIN;
constexpr size_t OFF_MOD = OFF_ODOUT + 2 * SZ_OUT;
constexpr size_t OFF_XCTX = OFF_MOD + (size_t)4 * 9 * 6144 * 4;
constexpr size_t OFF_H = OFF_XCTX + (size_t)2048 * 1024 * 4;
constexpr size_t OFF_XB = OFF_H;
constexpr size_t OFF_S = OFF_H + (size_t)R * 1024 * 2;
constexpr size_t SZ_S = (size_t)R * 4096 * 2;
constexpr size_t OFF_GATES = OFF_S + SZ_S;
constexpr size_t OFF_M = OFF_GATES + (size_t)R * 32 * 4;
constexpr size_t OFF_UE = OFF_S;
constexpr size_t OFF_Y = OFF_UE + (size_t)R * 2304 * 2;
constexpr size_t OFF_Q = OFF_Y + (size_t)2 * R * 512 * 2;
static_assert(OFF_Q + (size_t)R * 768 * 2 <= OFF_S + SZ_S, "S overflow even");
constexpr size_t OFF_KN = OFF_M;
constexpr size_t OFF_KR = OFF_KN + (size_t)R * 512 * 2;
constexpr size_t OFF_VTE = OFF_KR + (size_t)R * 32 * 2;
constexpr size_t OFF_XT = OFF_VTE + (size_t)R * 512 * 2;
constexpr size_t OFF_BM = OFF_XT + (size_t)R * 512 * 2;
constexpr size_t OFF_BMT = OFF_BM + (size_t)R * 256 * 2;
constexpr size_t OFF_CM = OFF_BMT + (size_t)R * 256 * 2;
constexpr size_t OFF_DT = OFF_CM + (size_t)R * 256 * 2;
constexpr size_t OFF_DA = OFF_DT + (size_t)R * 16 * 4;
constexpr size_t END_EVEN = OFF_DA + (size_t)R * 16 * 4;
constexpr size_t OFF_UO = OFF_S;
constexpr size_t OFF_HB = OFF_UO + (size_t)R * 2048 * 2;
static_assert(OFF_HB + (size_t)2 * R * 1024 * 2 <= OFF_S + SZ_S, "S overflow odd");
constexpr size_t OFF_QC = OFF_M;
constexpr size_t OFF_KC = OFF_QC + (size_t)R * 512 * 2;
constexpr size_t OFF_KT = OFF_KC + (size_t)R * 512 * 2;
constexpr size_t OFF_VTO = OFF_KT + (size_t)R * 512 * 2;
constexpr size_t END_ODD = OFF_VTO + (size_t)R * 1024 * 2;
constexpr size_t WS_NEED = END_ODD > END_EVEN ? END_ODD : END_EVEN;
constexpr size_t OFF_BAR = (WS_NEED + 255) / 256 * 256;
constexpr size_t WS_TOTAL = OFF_BAR + 16384;
static_assert(WS_TOTAL <= (size_t)402000000, "workspace too large");

struct WDesc { const float* src; bf16_t* dst; int K, N, Npad, tstart; };

struct Params {
  const float *x, *c, *ctx, *c_ctx, *ada_w, *ada_b, *norm_mix_w, *norm_mlp_w, *mlp_w1, *mlp_w2;
  const float *ev_w_in, *ev_q_norm_w, *ev_w_uq, *ev_kv_norm_w, *ev_w_ukv, *ev_conv_w, *ev_conv_b, *ev_dt_bias, *ev_a_log, *ev_d_skip, *ev_ssm_norm_w, *ev_w_out;
  const float *od_w_in, *od_conv_w, *od_conv_b, *od_i_bias, *od_f_bias, *od_head_norm_w, *od_w_out, *final_norm_w;
  float* out; char* ws;
  int ph_begin, ph_end, coop, pad0;
};

__device__ __forceinline__ int tidx() { int t = threadIdx.x; asm volatile("" : "+v"(t)); return t; }
__device__ __forceinline__ int bidx() { int t = blockIdx.x; asm volatile("" : "+s"(t)); return t; }
__device__ __forceinline__ unsigned short f2bf(float f) {
  unsigned u = __float_as_uint(f);
  u += 0x7fffu + ((u >> 16) & 1u);
  return (unsigned short)(u >> 16);
}
__device__ __forceinline__ float bf2f(unsigned short h) { return __uint_as_float(((unsigned)h) << 16); }
__device__ __forceinline__ unsigned pack2(float a, float b) { unsigned r; asm("v_cvt_pk_bf16_f32 %0, %1, %2" : "=v"(r) : "v"(a), "v"(b)); return r; }
__device__ __forceinline__ uint2 pack4(f32x4 v) { return make_uint2(pack2(v[0], v[1]), pack2(v[2], v[3])); }
__device__ __forceinline__ bf16x8 pack8(f32x4 a, f32x4 b) {
  union { bf16x8 v; unsigned u[4]; } r;
  r.u[0] = pack2(a[0], a[1]); r.u[1] = pack2(a[2], a[3]); r.u[2] = pack2(b[0], b[1]); r.u[3] = pack2(b[2], b[3]);
  return r.v;
}
__device__ __forceinline__ bf16x8 cat44(uint2 a, uint2 b) {
  union { bf16x8 v; unsigned u[4]; } r;
  r.u[0] = a.x; r.u[1] = a.y; r.u[2] = b.x; r.u[3] = b.y;
  return r.v;
}
__device__ __forceinline__ f32x4 mfma16(bf16x8 a, bf16x8 b, f32x4 c) { return __builtin_amdgcn_mfma_f32_16x16x32_bf16(a, b, c, 0, 0, 0); }
__device__ __forceinline__ float wave_sum(float v) {
#pragma unroll
  for (int o = 32; o > 0; o >>= 1) v += __shfl_xor(v, o);
  return v;
}
__device__ __forceinline__ float scan_add(float v, int lane) {
#pragma unroll
  for (int o = 1; o < 64; o <<= 1) { float t = __shfl_up(v, o); if (lane >= o) v += t; }
  return v;
}
__device__ __forceinline__ float scan_max(float v, int lane) {
#pragma unroll
  for (int o = 1; o < 64; o <<= 1) { float t = __shfl_up(v, o); if (lane >= o) v = fmaxf(v, t); }
  return v;
}
__device__ __forceinline__ float siluf(float v) { return v * __builtin_amdgcn_rcpf(1.f + __expf(-v)); }
__device__ __forceinline__ float sigmoidf(float v) { return __builtin_amdgcn_rcpf(1.f + __expf(-v)); }
__device__ __forceinline__ float softplusf(float v) { return fmaxf(v, 0.f) + __logf(1.f + __expf(-fabsf(v))); }
__device__ __forceinline__ float* xrow(const Params& p, int r) {
  int b = r / LB, s = r - b * LB;
  return s < 2048 ? p.out + (size_t)(b * 2048 + s) * DM : (float*)(p.ws + OFF_XCTX) + (size_t)(b * 256 + (s - 2048)) * DM;
}
__device__ __forceinline__ void rope8(const float* own, const float* par, float pos, bool hi, float* o) {
  const float inv[8] = {1.f, 0.316227766f, 0.1f, 0.0316227766f, 0.01f, 0.00316227766f, 0.001f, 0.000316227766f};
#pragma unroll
  for (int i = 0; i < 8; ++i) {
    float ang = pos * inv[i];
    float k = rintf(ang * 0.15915494309f);
    ang = ang - k * 6.28318530718f;
    float sn = __sinf(ang), cs = __cosf(ang);
    o[i] = hi ? own[i] * cs + par[i] * sn : own[i] * cs - par[i] * sn;
  }
}
__device__ __forceinline__ void unpack8(uint4 v, float* f) {
  f[0] = __uint_as_float(v.x << 16); f[1] = __uint_as_float(v.x & 0xffff0000u);
  f[2] = __uint_as_float(v.y << 16); f[3] = __uint_as_float(v.y & 0xffff0000u);
  f[4] = __uint_as_float(v.z << 16); f[5] = __uint_as_float(v.z & 0xffff0000u);
  f[6] = __uint_as_float(v.w << 16); f[7] = __uint_as_float(v.w & 0xffff0000u);
}
__device__ __forceinline__ uint4 packf8(const float* f) {
  return make_uint4(pack2(f[0], f[1]), pack2(f[2], f[3]), pack2(f[4], f[5]), pack2(f[6], f[7]));
}

__device__ void wt_tile_wave(const WDesc w, int t) {
  const int lane = tidx() & 63;
  const int nkt = w.K >> 6;
  const int ntile = t / nkt, ktile = t - ntile * nkt;
  const int kb = lane & 7, nb = lane >> 3;
  const int k0 = ktile * 64 + kb * 8, n0 = ntile * 64 + nb * 8;
  float v[8][8];
  if (n0 + 8 <= w.N) {
#pragma unroll
    for (int kk = 0; kk < 8; ++kk) {
      const float* src = w.src + (size_t)(k0 + kk) * w.N + n0;
      float4 a = *(const float4*)src, b = *(const float4*)(src + 4);
      v[kk][0] = a.x; v[kk][1] = a.y; v[kk][2] = a.z; v[kk][3] = a.w; v[kk][4] = b.x; v[kk][5] = b.y; v[kk][6] = b.z; v[kk][7] = b.w;
    }
  } else {
#pragma unroll
    for (int kk = 0; kk < 8; ++kk)
#pragma unroll
      for (int e = 0; e < 8; ++e) v[kk][e] = 0.f;
  }
#pragma unroll
  for (int e = 0; e < 8; ++e) {
    uint4 o = make_uint4(pack2(v[0][e], v[1][e]), pack2(v[2][e], v[3][e]), pack2(v[4][e], v[5][e]), pack2(v[6][e], v[7][e]));
    *(uint4*)(w.dst + (size_t)(n0 + e) * w.K + k0) = o;
  }
}

__device__ void ada_tile(const Params& p, int t, char* smem) {
  const int tid = tidx(), lane = tid & 63, wave = __builtin_amdgcn_readfirstlane(tid >> 6);
  const int l = t / 192, cgp = t - l * 192;
  float* sv = (float*)smem;
  float* red = sv + 9 * 1024;
  for (int idx = tid; idx < 9 * 1024; idx += NT) {
    int r = idx >> 10, k = idx & 1023;
    float v = r < 8 ? p.c[r * 1024 + k] : p.c_ctx[k];
    sv[idx] = siluf(v);
  }
  __syncthreads();
  const int cl = lane & 7, rg = lane >> 3;
  const float* wp = p.ada_w + (size_t)l * 1024 * 6144 + cgp * 32 + cl * 4;
  const int kb = wave * 128 + rg;
  float4 wv[16];
#pragma unroll
  for (int it = 0; it < 16; ++it) wv[it] = *(const float4*)(wp + (size_t)(kb + it * 8) * 6144);
  float acc[9][4];
#pragma unroll
  for (int r = 0; r < 9; ++r) { acc[r][0] = 0.f; acc[r][1] = 0.f; acc[r][2] = 0.f; acc[r][3] = 0.f; }
#pragma unroll
  for (int it = 0; it < 16; ++it) {
    const int k = kb + it * 8;
#pragma unroll
    for (int r = 0; r < 9; ++r) {
      const float sx = sv[r * 1024 + k];
      acc[r][0] += sx * wv[it].x; acc[r][1] += sx * wv[it].y; acc[r][2] += sx * wv[it].z; acc[r][3] += sx * wv[it].w;
    }
  }
#pragma unroll
  for (int r = 0; r < 9; ++r)
#pragma unroll
    for (int e = 0; e < 4; ++e) {
      float v = acc[r][e];
      v += __shfl_xor(v, 8); v += __shfl_xor(v, 16); v += __shfl_xor(v, 32);
      acc[r][e] = v;
    }
  if (rg == 0) {
#pragma unroll
    for (int r = 0; r < 9; ++r)
#pragma unroll
      for (int e = 0; e < 4; ++e) red[(wave * 9 + r) * 32 + cl * 4 + e] = acc[r][e];
  }
  __syncthreads();
  float* mod = (float*)(p.ws + OFF_MOD);
  if (tid < 9 * 32) {
    int r = tid >> 5, cc = tid & 31;
    float sacc = 0.f;
#pragma unroll
    for (int w = 0; w < 8; ++w) sacc += red[(w * 9 + r) * 32 + cc];
    mod[((size_t)l * 9 + r) * 6144 + cgp * 32 + cc] = sacc + p.ada_b[l * 6144 + cgp * 32 + cc];
  }
  __syncthreads();
}

__device__ __forceinline__ bool wsel(int& tt, int cnt, int per, int& idx) {
  if (tt < cnt * per) { idx = tt / per; tt -= idx * per; return true; }
  tt -= cnt * per; return false;
}
constexpr int N_WTILES = 4 * 1024 + 4 * 1024 + 2 * (576 + 48 + 64 + 256 + 832 + 256);
__device__ void setup_phase(const Params& p, char* smem) {
  for (int t = bidx(); t < 768; t += gridDim.x) ada_tile(p, t, smem);
  const int wave = __builtin_amdgcn_readfirstlane(tidx() >> 6);
  for (int t = bidx() * 8 + wave; t < N_WTILES; t += gridDim.x * 8) {
    int tt = t, i = 0;
    WDesc w; w.tstart = 0;
    if (wsel(tt, 4, 1024, i)) { w.src = p.mlp_w1 + (size_t)i * 1024 * 4096; w.dst = (bf16_t*)(p.ws + OFF_W1 + i * SZ_W1); w.K = 1024; w.N = 4096; }
    else if (wsel(tt, 4, 1024, i)) { w.src = p.mlp_w2 + (size_t)i * 1024 * 4096; w.dst = (bf16_t*)(p.ws + OFF_W2 + i * SZ_W2); w.K = 4096; w.N = 1024; }
    else if (wsel(tt, 2, 576, i)) { w.src = p.ev_w_in + (size_t)i * 1024 * 2096; w.dst = (bf16_t*)(p.ws + OFF_EVIN + i * SZ_EVIN); w.K = 1024; w.N = 2096; }
    else if (wsel(tt, 2, 48, i)) { w.src = p.ev_w_uq + (size_t)i * 256 * 768; w.dst = (bf16_t*)(p.ws + OFF_UQ + i * SZ_UQ); w.K = 256; w.N = 768; }
    else if (wsel(tt, 2, 64, i)) { w.src = p.ev_w_ukv + (size_t)i * 256 * 1024; w.dst = (bf16_t*)(p.ws + OFF_UKV + i * SZ_UKV); w.K = 256; w.N = 1024; }
    else if (wsel(tt, 2, 256, i)) { w.src = p.ev_w_out + (size_t)i * 1024 * 1024; w.dst = (bf16_t*)(p.ws + OFF_EVOUT + i * SZ_OUT); w.K = 1024; w.N = 1024; }
    else if (wsel(tt, 2, 832, i)) { w.src = p.od_w_in + (size_t)i * 1024 * 3104; w.dst = (bf16_t*)(p.ws + OFF_ODIN + i * SZ_ODIN); w.K = 1024; w.N = 3104; }
    else { wsel(tt, 2, 256, i); w.src = p.od_w_out + (size_t)i * 1024 * 1024; w.dst = (bf16_t*)(p.ws + OFF_ODOUT + i * SZ_OUT); w.K = 1024; w.N = 1024; }
    w.Npad = 0;
    wt_tile_wave(w, tt);
  }
  bf16_t* xbw = (bf16_t*)(p.ws + OFF_XB);
  for (size_t i = (size_t)bidx() * NT + tidx(); i < (size_t)R * DM / 8; i += (size_t)gridDim.x * NT) {
    const int r = (int)(i >> 7), c8 = (int)(i & 127) * 8;
    const int b = r / LB, sq = r - b * LB;
    const float* src = (sq < 2048 ? p.x + (size_t)(b * 2048 + sq) * DM : p.ctx + (size_t)(b * 256 + (sq - 2048)) * DM) + c8;
    const float4 f0 = *(const float4*)src, f1 = *(const float4*)(src + 4);
    *(uint4*)(xbw + (size_t)r * DM + c8) = make_uint4(pack2(f0.x, f0.y), pack2(f0.z, f0.w), pack2(f1.x, f1.y), pack2(f1.z, f1.w));
  }
}

__device__ void norm_phase(const Params& p, int layer, int which, bool skip_ctx) {
  const int lane = tidx() & 63, wave = __builtin_amdgcn_readfirstlane(tidx() >> 6);
  const float* w = (which ? p.norm_mlp_w : p.norm_mix_w) + layer * DM;
  const float* mod = (const float*)(p.ws + OFF_MOD) + (size_t)layer * 9 * 6144;
  bf16_t* h = (bf16_t*)((char*)p.out);
  const bf16_t* xb = (const bf16_t*)(p.ws + OFF_XB);
  const int c0 = lane * 16;
  float wr[16];
#pragma unroll
  for (int k = 0; k < 4; ++k) { float4 t = *(const float4*)(w + c0 + k * 4); wr[k * 4] = t.x; wr[k * 4 + 1] = t.y; wr[k * 4 + 2] = t.z; wr[k * 4 + 3] = t.w; }
  const int nwv = gridDim.x * 8;
  for (int r0 = bidx() * 8 + wave; r0 < R; r0 += nwv * 3) {
    uint4 q[3][2]; bool ok[3]; int mrr[3];
#pragma unroll
    for (int u = 0; u < 3; ++u) {
      const int r = r0 + u * nwv;
      const int b = r / LB, s = r - b * LB;
      ok[u] = (r < R) && !(skip_ctx && s >= 2048);
      mrr[u] = s < 2048 ? b : 8;
      if (ok[u]) { q[u][0] = *(const uint4*)(xb + (size_t)r * DM + c0); q[u][1] = *(const uint4*)(xb + (size_t)r * DM + c0 + 8); }
    }
#pragma unroll
    for (int u = 0; u < 3; ++u) {
      if (!ok[u]) continue;
      const int r = r0 + u * nwv;
      float f[16]; unpack8(q[u][0], f); unpack8(q[u][1], f + 8);
      float ss = 0.f;
#pragma unroll
      for (int k = 0; k < 16; ++k) ss += f[k] * f[k];
      ss = wave_sum(ss);
      const float rstd = rsqrtf(ss * (1.f / 1024.f) + EPS);
      const float* sh = mod + (size_t)mrr[u] * 6144 + (which ? 3072 : 0) + c0;
      const float* sc = sh + 1024;
#pragma unroll
      for (int k = 0; k < 4; ++k) {
        const float4 s4 = *(const float4*)(sh + k * 4), c4 = *(const float4*)(sc + k * 4);
        f[k * 4]     = f[k * 4]     * rstd * wr[k * 4]     * (1.f + c4.x) + s4.x;
        f[k * 4 + 1] = f[k * 4 + 1] * rstd * wr[k * 4 + 1] * (1.f + c4.y) + s4.y;
        f[k * 4 + 2] = f[k * 4 + 2] * rstd * wr[k * 4 + 2] * (1.f + c4.z) + s4.z;
        f[k * 4 + 3] = f[k * 4 + 3] * rstd * wr[k * 4 + 3] * (1.f + c4.w) + s4.w;
      }
      *(uint4*)(h + (size_t)r * DM + c0) = packf8(f);
      *(uint4*)(h + (size_t)r * DM + c0 + 8) = packf8(f + 8);
    }
  }
}

__device__ void final_phase(const Params& p) {
  const int lane = tidx() & 63, wave = __builtin_amdgcn_readfirstlane(tidx() >> 6);
  for (int r = bidx() * 8 + wave; r < NB * 2048; r += gridDim.x * 8) {
    const int b = r >> 11, t = r & 2047;
    const bf16_t* xr = (const bf16_t*)(p.ws + OFF_XB) + (size_t)(b * LB + t) * DM;
    float4 v[4]; float ss = 0.f;
    uint2 q_[4];
#pragma unroll
    for (int i = 0; i < 4; ++i) q_[i] = *(const uint2*)(xr + i * 256 + lane * 4);
#pragma unroll
    for (int i = 0; i < 4; ++i) {
      v[i].x = __uint_as_float(q_[i].x << 16); v[i].y = __uint_as_float(q_[i].x & 0xffff0000u);
      v[i].z = __uint_as_float(q_[i].y << 16); v[i].w = __uint_as_float(q_[i].y & 0xffff0000u);
      ss += v[i].x * v[i].x + v[i].y * v[i].y + v[i].z * v[i].z + v[i].w * v[i].w;
    }
    ss = wave_sum(ss);
    float rstd = rsqrtf(ss * (1.f / 1024.f) + EPS);
#pragma unroll
    for (int i = 0; i < 4; ++i) {
      int col = i * 256 + lane * 4;
      float4 w4 = *(const float4*)(p.final_norm_w + col);
      float4 o = make_float4(v[i].x * rstd * w4.x, v[i].y * rstd * w4.y, v[i].z * rstd * w4.z, v[i].w * rstd * w4.w);
      *(float4*)(p.out + (size_t)r * DM + col) = o;
    }
  }
}

enum { EPI_U_EVEN = 0, EPI_U_ODD, EPI_Q, EPI_KV, EPI_RESID, EPI_SQRELU };
struct GemmDesc { const bf16_t* A; int lda; const bf16_t* W; int K; int ntn; int epi; int layer; int gate_off; int skip_ctx; };

__device__ __forceinline__ int lds_byte2(int r, int c) {
  int st = (r >> 4) * 2 + (c >> 5), ob = (r & 15) * 64 + (c & 31) * 2;
  return st * 1024 + (ob ^ (((ob >> 9) & 1) << 5));
}
__device__ __forceinline__ void stage_rc2(int b, int& R, int& C) {
  int st = b >> 10, sb = b & 1023, swz = sb ^ (((sb >> 9) & 1) << 5);
  R = (st >> 1) * 16 + swz / 64;
  C = (st & 1) * 32 + (swz % 64) / 2;
}
#define GLDS16(gp, lp) __builtin_amdgcn_global_load_lds((const __attribute__((address_space(1))) unsigned*)(gp), (__attribute__((address_space(3))) unsigned*)(lp), 16, 0, 0)

__device__ void gemm_tile(const Params& p, const GemmDesc& g, int mt, int nt, char* smem, const int nrt,
                          const bf16_t* Ag_n, const bf16_t* Wg_n, const bool has_next, const bool first) {
  constexpr int MI = 8;
  const int BMR = nrt * 16;
  const int TA = BMR * 128;
  constexpr int TB = 256 * 128;
  const int STG = TA + TB;
  constexpr int GLB = TB / 8192;
  const int tid = tidx(), lane = tid & 63, wave = __builtin_amdgcn_readfirstlane(tid >> 6), l15 = lane & 15, quad = lane >> 4;
  const int wm = wave >> 2, wn = wave & 3;
  const int base_rt = wm * ((nrt + 1) >> 1);
  const int cnt = wm ? (nrt >> 1) : ((nrt + 1) >> 1);
  const int m0 = mt * BMR, n0 = nt * 256;
  const int K = g.K, lda = g.lda;
  const bf16_t* Ag = g.A + (size_t)m0 * lda;
  const bf16_t* Wg = g.W + (size_t)n0 * K;
  f32x4 acc[MI][4];
#pragma unroll
  for (int i = 0; i < MI; ++i)
#pragma unroll
    for (int j = 0; j < 4; ++j) acc[i][j] = (f32x4){0.f, 0.f, 0.f, 0.f};
  const int nk = K >> 6;
  const int nw = n0 + wn * 64;
  int R0, C0;
  stage_rc2(wave * 1024 + lane * 16, R0, C0);
  const int R0b = (R0 & ~31) + 8 * ((R0 & 15) >> 2) + 4 * ((R0 >> 4) & 1) + (R0 & 3);
  const int offA = R0 * lda + C0, offB = R0b * K + C0;
#define GSTAGE(A_, W_, buf, kt) do { \
    const bf16_t* ak_ = (A_) + (kt) * 64; const bf16_t* wk_ = (W_) + (kt) * 64; \
    _Pragma("unroll") for (int i_ = 0; i_ < GLB; ++i_) if (wave + 8 * i_ < 2 * nrt) GLDS16(ak_ + (size_t)(i_ * 64) * lda + offA, smem + (buf) * STG + wave * 1024 + i_ * 8192); \
    _Pragma("unroll") for (int i_ = 0; i_ < GLB; ++i_) GLDS16(wk_ + (size_t)(i_ * 64) * K + offB, smem + (buf) * STG + TA + wave * 1024 + i_ * 8192); } while (0)
  const int ob_ = l15 * 64 + quad * 16;
  const int lane_off = ob_ ^ (((ob_ >> 9) & 1) << 5);
  const int a_off = lane_off + base_rt * 2048;
  const int b_off = lane_off + TA + (wn * 4) * 2048;
#define LDA_LO(A_, base, ks) do { _Pragma("unroll") for (int i_ = 0; i_ < 4; ++i_) A_[i_] = *(const bf16x8*)((base) + a_off + (i_ * 2 + (ks)) * 1024); } while (0)
#define LDA_HI(A_, base, ks) do { if (cnt > 4) { A_[0] = *(const bf16x8*)((base) + a_off + (4 * 2 + (ks)) * 1024); \
    if (cnt > 5) { A_[1] = *(const bf16x8*)((base) + a_off + (5 * 2 + (ks)) * 1024); \
    if (cnt == 8) { _Pragma("unroll") for (int i_ = 6; i_ < 8; ++i_) A_[i_ - 4] = *(const bf16x8*)((base) + a_off + (i_ * 2 + (ks)) * 1024); } } } } while (0)
#define LDB_F(B_, base, ks) do { _Pragma("unroll") for (int j_ = 0; j_ < 4; ++j_) B_[j_] = *(const bf16x8*)((base) + b_off + (j_ * 2 + (ks)) * 1024); } while (0)
#define MMA_LO(A_, B_) do { _Pragma("unroll") for (int i_ = 0; i_ < 4; ++i_) { _Pragma("unroll") for (int j_ = 0; j_ < 4; ++j_) acc[i_][j_] = mfma16(B_[j_], A_[i_], acc[i_][j_]); } } while (0)
#define MMA_HI(A_, B_) do { if (cnt > 4) { _Pragma("unroll") for (int j_ = 0; j_ < 4; ++j_) acc[4][j_] = mfma16(B_[j_], A_[0], acc[4][j_]); \
    if (cnt > 5) { _Pragma("unroll") for (int j_ = 0; j_ < 4; ++j_) acc[5][j_] = mfma16(B_[j_], A_[1], acc[5][j_]); \
    if (cnt == 8) { _Pragma("unroll") for (int i_ = 6; i_ < 8; ++i_) { _Pragma("unroll") for (int j_ = 0; j_ < 4; ++j_) acc[i_][j_] = mfma16(B_[j_], A_[i_ - 4], acc[i_][j_]); } } } } } while (0)
#define SB_ __builtin_amdgcn_sched_barrier(0)
  bf16x8 aL[4], aH[4], bX[4], bY[4];
  if (first) GSTAGE(Ag, Wg, 0, 0);
  asm volatile("s_waitcnt vmcnt(0)" ::: "memory");
  __syncthreads();
  LDA_LO(aL, smem, 0); LDB_F(bX, smem, 0);
#pragma unroll 1
  for (int kt = 0; kt < nk; ++kt) {
    const int buf = kt & 1;
    const char* cur = smem + buf * STG;
    const char* nxt = smem + (buf ^ 1) * STG;
    if (kt + 1 < nk) GSTAGE(Ag, Wg, buf ^ 1, kt + 1);
    else if (has_next) GSTAGE(Ag_n, Wg_n, buf ^ 1, 0);
    LDA_HI(aH, cur, 0); SB_; MMA_LO(aL, bX); SB_;
    LDA_LO(aL, cur, 1); LDB_F(bY, cur, 1); SB_; MMA_HI(aH, bX); SB_;
    LDA_HI(aH, cur, 1); SB_; MMA_LO(aL, bY); SB_;
    asm volatile("s_waitcnt vmcnt(0)" ::: "memory");
    __syncthreads();
    if (kt + 1 < nk) { LDA_LO(aL, nxt, 0); LDB_F(bX, nxt, 0); }
    SB_; MMA_HI(aH, bY); SB_;
  }
#undef LDA_LO
#undef LDA_HI
#undef LDB_F
#undef MMA_LO
#undef MMA_HI
#undef SB_
#undef GSTAGE

  const float* mod = (const float*)(p.ws + OFF_MOD) + (size_t)g.layer * 9 * 6144;
#pragma unroll
  for (int i = 0; i < MI; ++i) {
    if (i >= cnt) break;
    const int m = m0 + (base_rt + i) * 16 + l15;
    const int bb_ = m / LB, ss_ = m - bb_ * LB;
#pragma unroll
    for (int t = 0; t < 2; ++t) {
      const f32x4 v0 = acc[i][2 * t], v1 = acc[i][2 * t + 1];
      const int n = nw + t * 32 + quad * 8;
      const uint4 pk = make_uint4(pack2(v0[0], v0[1]), pack2(v0[2], v0[3]), pack2(v1[0], v1[1]), pack2(v1[2], v1[3]));
      switch (g.epi) {
        case EPI_U_EVEN: {
          if (n < 2096) *(uint4*)((bf16_t*)(p.ws + OFF_UE) + (size_t)m * 2304 + n) = pk;
          if (n >= 2080 && n < 2096) {
            float* gp = (float*)(p.ws + OFF_GATES) + (size_t)m * 32 + (n - 2080);
            *(float4*)gp = make_float4(v0[0], v0[1], v0[2], v0[3]); *(float4*)(gp + 4) = make_float4(v1[0], v1[1], v1[2], v1[3]);
          }
        } break;
        case EPI_U_ODD: {
          if (n < 1024) *(uint4*)((bf16_t*)(p.ws + OFF_UO) + (size_t)m * 2048 + n) = pk;
          else if (n < 2048) {
            bf16_t* vt = (bf16_t*)(p.ws + OFF_VTO) + ((size_t)(bb_ * 1024 + (n - 1024))) * LB + ss_;
            vt[0] = (bf16_t)(pk.x & 0xffffu); vt[(size_t)1 * LB] = (bf16_t)(pk.x >> 16); vt[(size_t)2 * LB] = (bf16_t)(pk.y & 0xffffu); vt[(size_t)3 * LB] = (bf16_t)(pk.y >> 16);
            vt[(size_t)4 * LB] = (bf16_t)(pk.z & 0xffffu); vt[(size_t)5 * LB] = (bf16_t)(pk.z >> 16); vt[(size_t)6 * LB] = (bf16_t)(pk.w & 0xffffu); vt[(size_t)7 * LB] = (bf16_t)(pk.w >> 16);
          }
          else if (n < 3072) *(uint4*)((bf16_t*)(p.ws + OFF_UO) + (size_t)m * 2048 + (n - 1024)) = pk;
          else if (n < 3104) {
            float* gp = (float*)(p.ws + OFF_GATES) + (size_t)m * 32 + (n - 3072);
            *(float4*)gp = make_float4(v0[0], v0[1], v0[2], v0[3]); *(float4*)(gp + 4) = make_float4(v1[0], v1[1], v1[2], v1[3]);
          }
        } break;
        case EPI_Q: {
          *(uint4*)((bf16_t*)(p.ws + OFF_Q) + (size_t)m * 768 + n) = pk;
        } break;
        case EPI_KV: {
          const int hh = n >> 7, wi = n & 127;
          if (wi < 64) *(uint4*)((bf16_t*)(p.ws + OFF_KN) + (size_t)m * 512 + hh * 64 + wi) = pk;
          else {
            bf16_t* vt = (bf16_t*)(p.ws + OFF_VTE) + ((size_t)(bb_ * 512 + hh * 64 + (wi - 64))) * LB + ss_;
            vt[0] = (bf16_t)(pk.x & 0xffffu); vt[(size_t)1 * LB] = (bf16_t)(pk.x >> 16); vt[(size_t)2 * LB] = (bf16_t)(pk.y & 0xffffu); vt[(size_t)3 * LB] = (bf16_t)(pk.y >> 16);
            vt[(size_t)4 * LB] = (bf16_t)(pk.z & 0xffffu); vt[(size_t)5 * LB] = (bf16_t)(pk.z >> 16); vt[(size_t)6 * LB] = (bf16_t)(pk.w & 0xffffu); vt[(size_t)7 * LB] = (bf16_t)(pk.w >> 16);
          }
        } break;
        case EPI_RESID: {
          const int mr = ss_ < 2048 ? bb_ : 8;
          const float* gp = mod + (size_t)mr * 6144 + g.gate_off + n;
          const float4 g0 = *(const float4*)gp, g1 = *(const float4*)(gp + 4);
          bf16_t* xp = (bf16_t*)(p.ws + OFF_XB) + (size_t)m * DM + n;
          float xf[8]; unpack8(*(const uint4*)xp, xf);
          xf[0] += g0.x * v0[0]; xf[1] += g0.y * v0[1]; xf[2] += g0.z * v0[2]; xf[3] += g0.w * v0[3];
          xf[4] += g1.x * v1[0]; xf[5] += g1.y * v1[1]; xf[6] += g1.z * v1[2]; xf[7] += g1.w * v1[3];
          *(uint4*)xp = packf8(xf);
        } break;
        case EPI_SQRELU: {
          float q[8];
#pragma unroll
          for (int e = 0; e < 4; ++e) { float a_ = fmaxf(v0[e], 0.f), b_ = fmaxf(v1[e], 0.f); q[e] = a_ * a_; q[4 + e] = b_ * b_; }
          *(uint4*)((bf16_t*)(p.ws + OFF_S) + (size_t)m * 4096 + n) = make_uint4(pack2(q[0], q[1]), pack2(q[2], q[3]), pack2(q[4], q[5]), pack2(q[6], q[7]));
        } break;
      }
    }
  }
}

__device__ void conv_tile(const Params& p, int layer, bool even, int tt, int cgp, char* smem, const float (&wreg)[5][16], const float (&breg)[16]) {
  const int tid = tidx();
  const int tok = tid >> 3, sub = tid & 7;
  const int r0 = tt * 64, r = r0 + tok;
  const int b = r / LB, s = r - b * LB;
  const int lo = s < 2048 ? 0 : 2048, hi = s < 2048 ? 2048 : LB;
  const int li = layer >> 1;
  const int ch0 = cgp * 128 + sub * 16;
  const bf16_t* ub; int ldu;
  if (even) { ub = (const bf16_t*)(p.ws + OFF_UE) + 1056; ldu = 2304; }
  else { ub = (const bf16_t*)(p.ws + OFF_UO); ldu = 2048; }
  (void)li;
  float acc[16];
#pragma unroll
  for (int q = 0; q < 16; ++q) acc[q] = breg[q];
#pragma unroll
  for (int j = 0; j < 5; ++j) {
    int ss = s + j - 2;
    if (ss >= lo && ss < hi) {
      const bf16_t* src = ub + (size_t)(r + j - 2) * ldu + ch0;
      uint4 x0 = *(const uint4*)src, x1 = *(const uint4*)(src + 8);
      float xf[16]; unpack8(x0, xf); unpack8(x1, xf + 8);
#pragma unroll
      for (int q = 0; q < 16; ++q) acc[q] += wreg[j][q] * xf[q];
    }
  }
  const bool kscale = (!even) && cgp >= 4;
#pragma unroll
  for (int e = 0; e < 16; ++e) { float v = siluf(acc[e]); acc[e] = kscale ? v * 0.125f : v; }
  bf16_t* rm = nullptr; int ldr = 0, coff = 0;
  bf16_t* tr = nullptr; int trows = 0, troff = 0;
  if (even) {
    if (cgp < 4) { tr = (bf16_t*)(p.ws + OFF_XT); trows = 512; troff = cgp * 128; }
    else if (cgp < 6) { rm = (bf16_t*)(p.ws + OFF_BM); ldr = 256; coff = (cgp - 4) * 128; tr = (bf16_t*)(p.ws + OFF_BMT); trows = 256; troff = (cgp - 4) * 128; }
    else { rm = (bf16_t*)(p.ws + OFF_CM); ldr = 256; coff = (cgp - 6) * 128; }
  } else {
    if (cgp < 4) { rm = (bf16_t*)(p.ws + OFF_QC); ldr = 512; coff = cgp * 128; }
    else { rm = (bf16_t*)(p.ws + OFF_KC); ldr = 512; coff = (cgp - 4) * 128; tr = (bf16_t*)(p.ws + OFF_KT); trows = 512; troff = (cgp - 4) * 128; }
  }
  if (rm) {
    bf16_t* dst = rm + (size_t)r * ldr + coff + sub * 16;
    *(uint4*)dst = packf8(acc); *(uint4*)(dst + 8) = packf8(acc + 8);
  }
  if (tr) {
    bf16_t* T = (bf16_t*)smem;
#pragma unroll
    for (int e = 0; e < 16; ++e) T[(sub * 16 + e) * 72 + tok] = f2bf(acc[e]);
    __syncthreads();
    const int s0 = r0 - (r0 / LB) * LB, b0 = r0 / LB;
#pragma unroll
    for (int i = 0; i < 2; ++i) {
      int idx = tid + i * NT; int chl = idx >> 3, tc = idx & 7;
      *(uint4*)(tr + ((size_t)(b0 * trows + troff + chl)) * LB + s0 + tc * 8) = *(const uint4*)&T[chl * 72 + tc * 8];
    }
    __syncthreads();
  }
}

__device__ void misc_tile(const Params& p, int layer, int tt) {
  const int tid = tidx();
  const int tok = tid >> 3, sub = tid & 7;
  const int r = tt * 64 + tok;
  const int b = r / LB, s = r - b * LB;
  const int e = layer >> 1;
  bf16_t* u = (bf16_t*)(p.ws + OFF_UE) + (size_t)r * 2304;
#pragma unroll
  for (int part = 0; part < 2; ++part) {
    bf16_t* src = u + part * 256 + sub * 32;
    const float* nw = (part ? p.ev_kv_norm_w : p.ev_q_norm_w) + e * 256 + sub * 32;
    float f[32];
#pragma unroll
    for (int q = 0; q < 4; ++q) unpack8(*(const uint4*)(src + q * 8), f + q * 8);
    float ss = 0.f;
#pragma unroll
    for (int q = 0; q < 32; ++q) ss += f[q] * f[q];
    ss += __shfl_xor(ss, 1); ss += __shfl_xor(ss, 2); ss += __shfl_xor(ss, 4);
    float rstd = rsqrtf(ss * (1.f / 256.f) + EPS);
#pragma unroll
    for (int q = 0; q < 32; ++q) f[q] = f[q] * rstd * nw[q];
#pragma unroll
    for (int q = 0; q < 4; ++q) *(uint4*)(src + q * 8) = packf8(f + q * 8);
  }
  if (sub < 4) {
    const int gsel = sub >> 1; const bool hi = sub & 1;
    float x1[8], x2[8], o[8];
    unpack8(*(const uint4*)(u + 512 + gsel * 16), x1);
    unpack8(*(const uint4*)(u + 512 + gsel * 16 + 8), x2);
    if (s < 2048) {
      float pos = (float)(gsel ? (s & 63) : (s >> 6));
      rope8(hi ? x2 : x1, hi ? x1 : x2, pos, hi, o);
    } else {
#pragma unroll
      for (int i = 0; i < 8; ++i) o[i] = hi ? x2[i] : x1[i];
    }
    *(uint4*)((bf16_t*)(p.ws + OFF_KR) + (size_t)r * 32 + gsel * 16 + (hi ? 8 : 0)) = packf8(o);
  } else {
    const float* gt = (const float*)(p.ws + OFF_GATES) + (size_t)r * 32;
    float* dt = (float*)(p.ws + OFF_DT) + (size_t)r * 16;
    float* da = (float*)(p.ws + OFF_DA) + (size_t)r * 16;
#pragma unroll
    for (int i = 0; i < 4; ++i) {
      int idx = (sub - 4) * 4 + i;
      float d = softplusf(gt[idx] + p.ev_dt_bias[e * 16 + idx]);
      dt[idx] = d;
      da[idx] = -d * __expf(p.ev_a_log[e * 16 + idx]);
    }
  }
}

__device__ void conv_phase(const Params& p, int layer, bool even, char* smem) {
  const int ntt = R / 64;
  const int G = gridDim.x, bi = bidx();
  const bool fast = (G & 7) == 0;
  const int sub = tidx() & 7, li = layer >> 1;
  const float* cw = even ? p.ev_conv_w + li * 5 * 1024 : p.od_conv_w + li * 5 * 1024;
  const float* cb = even ? p.ev_conv_b + li * 1024 : p.od_conv_b + li * 1024;
  float wreg[5][16], breg[16];
  int cg_cur = -1;
  const int nit = fast ? ((ntt - (bi >> 3) + (G >> 3) - 1) / (G >> 3)) : ((ntt * 8 - bi + G - 1) / G);
  for (int it = 0; it < nit; ++it) {
    int cgp, tt;
    if (fast) { cgp = bi & 7; tt = (bi >> 3) + it * (G >> 3); }
    else { const int t = bi + it * G; cgp = t / ntt; tt = t - cgp * ntt; }
    if (cgp != cg_cur) {
      cg_cur = cgp;
      const int ch0 = cgp * 128 + sub * 16;
#pragma unroll
      for (int q = 0; q < 4; ++q) {
        float4 t4 = *(const float4*)(cb + ch0 + q * 4);
        breg[q * 4] = t4.x; breg[q * 4 + 1] = t4.y; breg[q * 4 + 2] = t4.z; breg[q * 4 + 3] = t4.w;
#pragma unroll
        for (int j = 0; j < 5; ++j) {
          float4 w4 = *(const float4*)(cw + j * 1024 + ch0 + q * 4);
          wreg[j][q * 4] = w4.x; wreg[j][q * 4 + 1] = w4.y; wreg[j][q * 4 + 2] = w4.z; wreg[j][q * 4 + 3] = w4.w;
        }
      }
    }
    conv_tile(p, layer, even, tt, cgp, smem, wreg, breg);
  }
  if (even) for (int t = bi; t < ntt; t += G) misc_tile(p, layer, t);
}

__device__ void attn_tile(const Params& p, int b, int hh, int qt, char* smem) {
  bf16_t* Ks = (bf16_t*)smem;
  bf16_t* Vs = Ks + 2 * 64 * 104;
  const int tid = tidx(), lane = tid & 63, wave = __builtin_amdgcn_readfirstlane(tid >> 6), l15 = lane & 15, quad = lane >> 4;
  const bf16_t* Qg = (const bf16_t*)(p.ws + OFF_Q);
  const bf16_t* KNg = (const bf16_t*)(p.ws + OFF_KN);
  const bf16_t* KRg = (const bf16_t*)(p.ws + OFF_KR);
  const bf16_t* VTg = (const bf16_t*)(p.ws + OFF_VTE);
  const bool is_ctx = (qt == 8);
  const int kbeg = is_ctx ? 2048 : 0;
  const int nkt = (LB - kbeg) / 64;
  bf16x8 qf[2][3];
#pragma unroll
  for (int qi = 0; qi < 2; ++qi) {
    const int sq = qt * 256 + wave * 32 + qi * 16 + l15;
    const bf16_t* qp = Qg + (size_t)(b * LB + sq) * 768 + hh * 96;
#pragma unroll
    for (int ks = 0; ks < 3; ++ks) qf[qi][ks] = *(const bf16x8*)(qp + ks * 32 + quad * 8);
    if (!is_ctx) {
      float own[8], par[8], o[8];
      unpack8(*(const uint4*)(qp + 64 + quad * 8), own);
      unpack8(*(const uint4*)(qp + 64 + (quad ^ 1) * 8), par);
      float pos = (float)((quad < 2) ? (sq >> 6) : (sq & 63));
      rope8(own, par, pos, (quad & 1) != 0, o);
      union { uint4 u; bf16x8 v; } cv; cv.u = packf8(o);
      qf[qi][2] = cv.v;
    }
  }
  f32x4 o[4][2];
#pragma unroll
  for (int i = 0; i < 4; ++i)
#pragma unroll
    for (int j = 0; j < 2; ++j) o[i][j] = (f32x4){0.f, 0.f, 0.f, 0.f};
  float mrun[2] = {-1e30f, -1e30f}, lrun[2] = {0.f, 0.f};
  uint4 rk0, rk1, rv;
  const int kr0 = tid >> 3, kc0 = (tid & 7) * 8;
  const int kr1 = tid >> 2, kc1 = (tid & 3) * 8;
#define ALOAD(kt) do { \
    const size_t rowb_ = (size_t)b * LB + kbeg + (kt) * 64; \
    rk0 = *(const uint4*)(KNg + (rowb_ + kr0) * 512 + hh * 64 + kc0); \
    if (tid < 256) rk1 = *(const uint4*)(KRg + (rowb_ + kr1) * 32 + kc1); \
    rv = *(const uint4*)(VTg + ((size_t)(b * 512 + hh * 64 + kr0)) * LB + kbeg + (kt) * 64 + kc0); } while (0)
#define ASTORE(buf) do { \
    *(uint4*)(Ks + ((buf) * 64 + kr0) * 104 + kc0) = rk0; \
    if (tid < 256) *(uint4*)(Ks + ((buf) * 64 + kr1) * 104 + 64 + kc1) = rk1; \
    *(uint4*)(Vs + ((buf) * 64 + kr0) * 72 + kc0) = rv; } while (0)
  __syncthreads();
  ALOAD(0); ASTORE(0);
  __syncthreads();
  const float SCALE = 0.10206207261596577f * 1.4426950408889634f;
#pragma unroll 1
  for (int kt = 0; kt < nkt; ++kt) {
    const int buf = kt & 1;
    if (kt + 1 < nkt) ALOAD(kt + 1);
    f32x4 sacc[4][2];
#pragma unroll
    for (int i = 0; i < 4; ++i)
#pragma unroll
      for (int j = 0; j < 2; ++j) sacc[i][j] = (f32x4){0.f, 0.f, 0.f, 0.f};
#pragma unroll
    for (int ks = 0; ks < 3; ++ks) {
#pragma unroll
      for (int kti = 0; kti < 4; ++kti) {
        bf16x8 kf = *(const bf16x8*)(Ks + (buf * 64 + kti * 16 + l15) * 104 + ks * 32 + quad * 8);
#pragma unroll
        for (int qi = 0; qi < 2; ++qi) sacc[kti][qi] = mfma16(kf, qf[qi][ks], sacc[kti][qi]);
      }
    }
#pragma unroll
    for (int qi = 0; qi < 2; ++qi) {
      float mx = -1e30f;
#pragma unroll
      for (int kti = 0; kti < 4; ++kti)
#pragma unroll
        for (int e = 0; e < 4; ++e) mx = fmaxf(mx, sacc[kti][qi][e]);
      mx = fmaxf(mx, __shfl_xor(mx, 16)); mx = fmaxf(mx, __shfl_xor(mx, 32));
      float mnew = fmaxf(mrun[qi], mx * SCALE);
      float alpha = __builtin_amdgcn_exp2f(mrun[qi] - mnew);
      mrun[qi] = mnew;
      float ls = 0.f;
#pragma unroll
      for (int kti = 0; kti < 4; ++kti)
#pragma unroll
        for (int e = 0; e < 4; ++e) { float pv = __builtin_amdgcn_exp2f(fmaf(sacc[kti][qi][e], SCALE, -mnew)); sacc[kti][qi][e] = pv; ls += pv; }
      lrun[qi] = lrun[qi] * alpha + ls;
#pragma unroll
      for (int dvt = 0; dvt < 4; ++dvt) o[dvt][qi] *= alpha;
    }
#pragma unroll
    for (int kp = 0; kp < 2; ++kp) {
      bf16x8 pf[2];
#pragma unroll
      for (int qi = 0; qi < 2; ++qi) pf[qi] = pack8(sacc[2 * kp][qi], sacc[2 * kp + 1][qi]);
#pragma unroll
      for (int dvt = 0; dvt < 4; ++dvt) {
        const bf16_t* vp = Vs + (buf * 64 + dvt * 16 + l15) * 72 + quad * 4;
        bf16x8 vf = cat44(*(const uint2*)(vp + (2 * kp) * 16), *(const uint2*)(vp + (2 * kp + 1) * 16));
#pragma unroll
        for (int qi = 0; qi < 2; ++qi) o[dvt][qi] = mfma16(vf, pf[qi], o[dvt][qi]);
      }
    }
    if (kt + 1 < nkt) ASTORE(buf ^ 1);
    __syncthreads();
  }
#undef ALOAD
#undef ASTORE
  bf16_t* cat = (bf16_t*)((char*)p.out);
#pragma unroll
  for (int qi = 0; qi < 2; ++qi) {
    float l = lrun[qi];
    l += __shfl_xor(l, 16); l += __shfl_xor(l, 32);
    float inv = __builtin_amdgcn_rcpf(l);
    const int sq = qt * 256 + wave * 32 + qi * 16 + l15;
#pragma unroll
    for (int dvt = 0; dvt < 4; ++dvt) {
      f32x4 v = o[dvt][qi] * inv;
      *(uint2*)(cat + (size_t)(b * LB + sq) * DM + hh * 64 + dvt * 16 + quad * 4) = pack4(v);
    }
  }
}

__device__ void ssd_tile(const Params& p, int e, int b, int d, int hh, char* smem) {
  bf16_t* Cm = (bf16_t*)smem;
  bf16_t* Bm = Cm + 128 * 136;
  bf16_t* BmT = Bm + 128 * 136;
  bf16_t* XT = BmT + 128 * 136;
  bf16_t* Hs = XT + 64 * 136;
  float* acum = (float*)(Hs + 64 * 136);
  float* toend = acum + 128;
  float* dts = toend + 128;
  float* scal = dts + 128;
  const int tid = tidx(), lane = tid & 63, wave = __builtin_amdgcn_readfirstlane(tid >> 6), l15 = lane & 15, quad = lane >> 4;
  const int g = hh >> 2;
  const float Dk = p.ev_d_skip[e * 8 + hh];
  const bf16_t* CMg = (const bf16_t*)(p.ws + OFF_CM);
  const bf16_t* BMg = (const bf16_t*)(p.ws + OFF_BM);
  const bf16_t* BMTg = (const bf16_t*)(p.ws + OFF_BMT);
  const bf16_t* XTg = (const bf16_t*)(p.ws + OFF_XT);
  const float* DTg = (const float*)(p.ws + OFF_DT);
  const float* DAg = (const float*)(p.ws + OFF_DA);
  bf16_t* Yg = (bf16_t*)(p.ws + OFF_Y) + (size_t)d * R * 512;
  f32x4 hst[4];
#pragma unroll
  for (int i = 0; i < 4; ++i) hst[i] = (f32x4){0.f, 0.f, 0.f, 0.f};
  __syncthreads();
  for (int idx = tid; idx < 64 * 136 / 8; idx += NT) *(uint4*)(Hs + idx * 8) = make_uint4(0, 0, 0, 0);
  const int tcol = wave * 16 + l15;
#pragma unroll 1
  for (int step = 0; step < 18; ++step) {
    const int chunk = d ? (17 - step) : (step < 2 ? 16 + step : step - 2);
    const int row0 = b * LB + chunk * 128, pos0 = chunk * 128;
    __syncthreads();
    if (wave == 0) {
      const int i0 = d ? 127 - 2 * lane : 2 * lane, i1 = d ? 126 - 2 * lane : 2 * lane + 1;
      float a0 = DAg[(size_t)(row0 + i0) * 16 + d * 8 + hh], a1 = DAg[(size_t)(row0 + i1) * 16 + d * 8 + hh];
      float t0 = DTg[(size_t)(row0 + i0) * 16 + d * 8 + hh], t1 = DTg[(size_t)(row0 + i1) * 16 + d * 8 + hh];
      float loc = a0 + a1;
      float incl = scan_add(loc, lane);
      float excl = incl - loc;
      float c0 = excl + a0, c1 = excl + loc;
      float total = __shfl(incl, 63);
      acum[i0] = c0; acum[i1] = c1;
      toend[i0] = __expf(total - c0) * t0; toend[i1] = __expf(total - c1) * t1;
      dts[i0] = t0; dts[i1] = t1;
      if (lane == 0) scal[0] = total;
    }
    uint4 rbt[4];
#pragma unroll
    for (int i = 0; i < 4; ++i) {
      int idx = tid + i * NT; int rr = idx >> 4, cc = (idx & 15) * 8;
      *(uint4*)(Cm + rr * 136 + cc) = *(const uint4*)(CMg + (size_t)(row0 + rr) * 256 + g * 128 + cc);
      *(uint4*)(Bm + rr * 136 + cc) = *(const uint4*)(BMg + (size_t)(row0 + rr) * 256 + g * 128 + cc);
      rbt[i] = *(const uint4*)(BMTg + ((size_t)(b * 256 + g * 128 + rr)) * LB + pos0 + cc);
    }
#pragma unroll
    for (int i = 0; i < 2; ++i) {
      int idx = tid + i * NT; int rr = idx >> 4, cc = (idx & 15) * 8;
      *(uint4*)(XT + rr * 136 + cc) = *(const uint4*)(XTg + ((size_t)(b * 512 + hh * 64 + rr)) * LB + pos0 + cc);
    }
    __syncthreads();
#pragma unroll
    for (int i = 0; i < 4; ++i) {
      int idx = tid + i * NT; int rr = idx >> 4, cc = (idx & 15) * 8;
      float f[8]; unpack8(rbt[i], f);
#pragma unroll
      for (int q = 0; q < 8; ++q) f[q] *= toend[cc + q];
      *(uint4*)(BmT + rr * 136 + cc) = packf8(f);
    }
    const float total = scal[0];
    const float act = acum[tcol];
    bf16x8 cfr[4];
#pragma unroll
    for (int ks = 0; ks < 4; ++ks) cfr[ks] = *(const bf16x8*)(Cm + tcol * 136 + ks * 32 + quad * 8);
    f32x4 y[4];
#pragma unroll
    for (int i = 0; i < 4; ++i) y[i] = (f32x4){0.f, 0.f, 0.f, 0.f};
#pragma unroll
    for (int ks = 0; ks < 4; ++ks)
#pragma unroll
      for (int pt = 0; pt < 4; ++pt) {
        bf16x8 af = *(const bf16x8*)(Hs + (pt * 16 + l15) * 136 + ks * 32 + quad * 8);
        y[pt] = mfma16(af, cfr[ks], y[pt]);
      }
    {
      float et = __expf(act);
#pragma unroll
      for (int pt = 0; pt < 4; ++pt) y[pt] *= et;
    }
    f32x4 w[8];
#pragma unroll
    for (int i = 0; i < 8; ++i) w[i] = (f32x4){0.f, 0.f, 0.f, 0.f};
#pragma unroll
    for (int ks = 0; ks < 4; ++ks)
#pragma unroll
      for (int st = 0; st < 8; ++st) {
        bf16x8 af = *(const bf16x8*)(Bm + (st * 16 + l15) * 136 + ks * 32 + quad * 8);
        w[st] = mfma16(af, cfr[ks], w[st]);
      }
#pragma unroll
    for (int st = 0; st < 8; ++st)
#pragma unroll
      for (int jj = 0; jj < 4; ++jj) {
        int s = st * 16 + quad * 4 + jj;
        bool valid = d ? (s >= tcol) : (s <= tcol);
        float dec = valid ? __expf(act - acum[s]) * dts[s] : 0.f;
        w[st][jj] = valid ? w[st][jj] * dec : 0.f;
      }
#pragma unroll
    for (int kp = 0; kp < 4; ++kp) {
      bf16x8 pf = pack8(w[2 * kp], w[2 * kp + 1]);
#pragma unroll
      for (int pt = 0; pt < 4; ++pt) {
        const bf16_t* vp = XT + (pt * 16 + l15) * 136 + quad * 4;
        bf16x8 vf = cat44(*(const uint2*)(vp + (2 * kp) * 16), *(const uint2*)(vp + (2 * kp + 1) * 16));
        y[pt] = mfma16(vf, pf, y[pt]);
      }
    }
    if (d == 0) {
#pragma unroll
      for (int pt = 0; pt < 4; ++pt)
#pragma unroll
        for (int jj = 0; jj < 4; ++jj) y[pt][jj] += Dk * bf2f(XT[(pt * 16 + quad * 4 + jj) * 136 + tcol]);
    }
#pragma unroll
    for (int pt = 0; pt < 4; ++pt)
      *(uint2*)(Yg + (size_t)(row0 + tcol) * 512 + hh * 64 + pt * 16 + quad * 4) = pack4(y[pt]);
    __syncthreads();
    {
      float edec = __expf(total);
#pragma unroll
      for (int pt = 0; pt < 4; ++pt) hst[pt] *= edec;
#pragma unroll
      for (int ks = 0; ks < 4; ++ks) {
        bf16x8 af = *(const bf16x8*)(BmT + (wave * 16 + l15) * 136 + ks * 32 + quad * 8);
#pragma unroll
        for (int pt = 0; pt < 4; ++pt) {
          bf16x8 bfv = *(const bf16x8*)(XT + (pt * 16 + l15) * 136 + ks * 32 + quad * 8);
          hst[pt] = mfma16(af, bfv, hst[pt]);
        }
      }
#pragma unroll
      for (int pt = 0; pt < 4; ++pt) *(uint2*)(Hs + (pt * 16 + l15) * 136 + wave * 16 + quad * 4) = pack4(hst[pt]);
    }
  }
  __syncthreads();
}

__device__ void mlstm_tile(const Params& p, int o_, int b, int d, int hh, int vh, char* smem) {
  bf16_t* Qs = (bf16_t*)smem;
  bf16_t* Ks = Qs + 128 * 72;
  bf16_t* KTs = Ks + 128 * 72;
  bf16_t* VT = KTs + 64 * 136;
  bf16_t* Cs = VT + 80 * 136;
  float* bb = (float*)(Cs + 80 * 72);
  float* icb = bb + 128;
  float* mts = icb + 128;
  float* wts = mts + 128;
  float* scal = wts + 128;
  const int tid = tidx(), lane = tid & 63, wave = __builtin_amdgcn_readfirstlane(tid >> 6), l15 = lane & 15, quad = lane >> 4;
  const float ib = p.od_i_bias[o_ * 16 + d * 8 + hh], fb = p.od_f_bias[o_ * 16 + d * 8 + hh];
  const bf16_t* QCg = (const bf16_t*)(p.ws + OFF_QC);
  const bf16_t* KCg = (const bf16_t*)(p.ws + OFF_KC);
  const bf16_t* KTg = (const bf16_t*)(p.ws + OFF_KT);
  const bf16_t* VTg = (const bf16_t*)(p.ws + OFF_VTO);
  const float* Gg = (const float*)(p.ws + OFF_GATES);
  bf16_t* Hg = (bf16_t*)(p.ws + OFF_HB) + (size_t)d * R * 1024;
  __syncthreads();
  for (int idx = tid; idx < 80 * 72 / 8; idx += NT) *(uint4*)(Cs + idx * 8) = make_uint4(0, 0, 0, 0);
  for (int idx = tid; idx < 16 * 136 / 8; idx += NT) {
    unsigned v = (idx < 136 / 8) ? 0x3F803F80u : 0u;
    *(uint4*)(VT + 64 * 136 + idx * 8) = make_uint4(v, v, v, v);
  }
  const int dkt = wave & 3, vbase = (wave >> 2) * 2;
  f32x4 cst[3];
#pragma unroll
  for (int i = 0; i < 3; ++i) cst[i] = (f32x4){0.f, 0.f, 0.f, 0.f};
  float m_in = 0.f;
  const int tcol = wave * 16 + l15;
  uint4 pq0, pq1, pk0, pk1, pv0, pv1, rkt0, rkt1;
  float pf0 = 0.f, pf1 = 0.f, pg0 = 0.f, pg1 = 0.f;
#define ML_FETCH1(i_, row0n_, pos0n_) do { const int idx_ = tid + (i_) * NT; const int rr_ = idx_ >> 3, cc_ = (idx_ & 7) * 8, r2_ = idx_ >> 4, c2_ = (idx_ & 15) * 8; \
      pq##i_ = *(const uint4*)(QCg + (size_t)((row0n_) + rr_) * 512 + hh * 64 + cc_); \
      pk##i_ = *(const uint4*)(KCg + (size_t)((row0n_) + rr_) * 512 + hh * 64 + cc_); \
      rkt##i_ = *(const uint4*)(KTg + ((size_t)(b * 512 + hh * 64 + r2_)) * LB + (pos0n_) + c2_); \
      pv##i_ = *(const uint4*)(VTg + ((size_t)(b * 1024 + hh * 128 + vh * 64 + r2_)) * LB + (pos0n_) + c2_); } while (0)
#define ML_FETCH(chunk_) do { const int row0n_ = b * LB + (chunk_) * 128, pos0n_ = (chunk_) * 128; \
    ML_FETCH1(0, row0n_, pos0n_); ML_FETCH1(1, row0n_, pos0n_); \
    if (wave == 0) { const int i0_ = d ? 127 - 2 * lane : 2 * lane, i1_ = d ? 126 - 2 * lane : 2 * lane + 1; \
      pf0 = Gg[(size_t)(row0n_ + i0_) * 32 + 16 + d * 8 + hh]; pf1 = Gg[(size_t)(row0n_ + i1_) * 32 + 16 + d * 8 + hh]; \
      pg0 = Gg[(size_t)(row0n_ + i0_) * 32 + d * 8 + hh]; pg1 = Gg[(size_t)(row0n_ + i1_) * 32 + d * 8 + hh]; } } while (0)
  ML_FETCH(d ? 17 : 16);
#pragma unroll 1
  for (int step = 0; step < 18; ++step) {
    const int chunk = d ? (17 - step) : (step < 2 ? 16 + step : step - 2);
    const int row0 = b * LB + chunk * 128, pos0 = chunk * 128;
    __syncthreads();
    if (wave == 0) {
      const int i0 = d ? 127 - 2 * lane : 2 * lane, i1 = d ? 126 - 2 * lane : 2 * lane + 1;
      const float f0 = pf0 + fb, f1 = pf1 + fb, g0 = pg0 + ib, g1 = pg1 + ib;
      float lf0 = -softplusf(-f0), lf1 = -softplusf(-f1);
      float loc = lf0 + lf1;
      float incl = scan_add(loc, lane);
      float excl = incl - loc;
      float b0 = excl + lf0, b1 = excl + loc;
      float blast = __shfl(incl, 63);
      float c0 = g0 - b0, c1 = g1 - b1;
      float lm = fmaxf(c0, c1);
      float pmi = scan_max(lm, lane);
      float pme = __shfl_up(pmi, 1); if (lane == 0) pme = -1e30f;
      float pm0 = fmaxf(pme, c0), pm1 = pmi;
      float mt0 = b0 + fmaxf(m_in, pm0), mt1 = b1 + fmaxf(m_in, pm1);
      float mw = blast + __shfl(pmi, 63);
      float m_new = fmaxf(blast + m_in, mw);
      float keepS = __expf(blast + m_in - m_new);
      bb[i0] = b0; bb[i1] = b1; icb[i0] = c0; icb[i1] = c1; mts[i0] = mt0; mts[i1] = mt1;
      wts[i0] = __expf(blast + c0 - m_new); wts[i1] = __expf(blast + c1 - m_new);
      if (lane == 0) { scal[0] = m_new; scal[1] = keepS; }
    }
    uint4 ckt0, ckt1;
    {
      int idx = tid; int rr = idx >> 3, cc = (idx & 7) * 8, r2 = idx >> 4, c2 = (idx & 15) * 8;
      *(uint4*)(Qs + rr * 72 + cc) = pq0; *(uint4*)(Ks + rr * 72 + cc) = pk0; *(uint4*)(VT + r2 * 136 + c2) = pv0; ckt0 = rkt0;
      idx = tid + NT; rr = idx >> 3; cc = (idx & 7) * 8; r2 = idx >> 4; c2 = (idx & 15) * 8;
      *(uint4*)(Qs + rr * 72 + cc) = pq1; *(uint4*)(Ks + rr * 72 + cc) = pk1; *(uint4*)(VT + r2 * 136 + c2) = pv1; ckt1 = rkt1;
    }
    if (step + 1 < 18) { const int nchunk = d ? (16 - step) : (step + 1 < 2 ? 17 : step - 1); ML_FETCH(nchunk); }
    __syncthreads();
    {
      int idx = tid; int r2 = idx >> 4, c2 = (idx & 15) * 8;
      float f[8]; unpack8(ckt0, f);
#pragma unroll
      for (int q = 0; q < 8; ++q) f[q] *= wts[c2 + q];
      *(uint4*)(KTs + r2 * 136 + c2) = packf8(f);
      idx = tid + NT; r2 = idx >> 4; c2 = (idx & 15) * 8;
      unpack8(ckt1, f);
#pragma unroll
      for (int q = 0; q < 8; ++q) f[q] *= wts[c2 + q];
      *(uint4*)(KTs + r2 * 136 + c2) = packf8(f);
    }
    const float m_new = scal[0], keepS = scal[1];
    const float bt = bb[tcol], mtt = mts[tcol];
    bf16x8 qfr[2];
#pragma unroll
    for (int ks = 0; ks < 2; ++ks) qfr[ks] = *(const bf16x8*)(Qs + tcol * 72 + ks * 32 + quad * 8);
    f32x4 a[8];
#pragma unroll
    for (int i = 0; i < 8; ++i) a[i] = (f32x4){0.f, 0.f, 0.f, 0.f};
#pragma unroll
    for (int ks = 0; ks < 2; ++ks)
#pragma unroll
      for (int st = 0; st < 8; ++st) {
        bf16x8 af = *(const bf16x8*)(Ks + (st * 16 + l15) * 72 + ks * 32 + quad * 8);
        a[st] = mfma16(af, qfr[ks], a[st]);
      }
#pragma unroll
    for (int st = 0; st < 8; ++st)
#pragma unroll
      for (int jj = 0; jj < 4; ++jj) {
        int s = st * 16 + quad * 4 + jj;
        bool valid = d ? (s >= tcol) : (s <= tcol);
        float dm = valid ? __expf(bt + icb[s] - mtt) : 0.f;
        a[st][jj] = valid ? a[st][jj] * dm : 0.f;
      }
    bf16x8 pfa[4];
#pragma unroll
    for (int kp = 0; kp < 4; ++kp) pfa[kp] = pack8(a[2 * kp], a[2 * kp + 1]);
    f32x4 nu[5];
#pragma unroll
    for (int i = 0; i < 5; ++i) nu[i] = (f32x4){0.f, 0.f, 0.f, 0.f};
#pragma unroll
    for (int ks = 0; ks < 2; ++ks)
#pragma unroll
      for (int vt = 0; vt < 5; ++vt) {
        bf16x8 af = *(const bf16x8*)(Cs + (vt * 16 + l15) * 72 + ks * 32 + quad * 8);
        nu[vt] = mfma16(af, qfr[ks], nu[vt]);
      }
    {
      float kt_ = __expf(bt + m_in - mtt);
#pragma unroll
      for (int vt = 0; vt < 5; ++vt) nu[vt] *= (DBG_NOSTATE ? 0.f : kt_);
    }
#pragma unroll
    for (int kp = 0; kp < 4; ++kp) {
      bf16x8 pf = pfa[kp];
#pragma unroll
      for (int vt = 0; vt < 5; ++vt) {
        const bf16_t* vp = VT + (vt * 16 + l15) * 136 + quad * 4;
        bf16x8 vf = cat44(*(const uint2*)(vp + (2 * kp) * 16), *(const uint2*)(vp + (2 * kp + 1) * 16));
        nu[vt] = mfma16(vf, pf, nu[vt]);
      }
    }
    {
      float den = __shfl(nu[4][0], l15);
      float dd = fmaxf(fabsf(den), __expf(-mtt));
      float inv = __builtin_amdgcn_rcpf(dd);
#pragma unroll
      for (int vt = 0; vt < 4; ++vt) {
        f32x4 v = nu[vt] * inv;
        *(uint2*)(Hg + (size_t)(row0 + tcol) * 1024 + hh * 128 + vh * 64 + vt * 16 + quad * 4) = pack4(v);
      }
    }
    __syncthreads();
#pragma unroll
    for (int k = 0; k < 3; ++k) cst[k] *= keepS;
#pragma unroll
    for (int ks = 0; ks < 4; ++ks) {
      bf16x8 af = *(const bf16x8*)(KTs + (dkt * 16 + l15) * 136 + ks * 32 + quad * 8);
#pragma unroll
      for (int k = 0; k < 3; ++k) {
        {
          const int vt_ = (k < 2) ? (vbase + k) : 4;
          bf16x8 bfv = *(const bf16x8*)(VT + (vt_ * 16 + l15) * 136 + ks * 32 + quad * 8);
          cst[k] = mfma16(af, bfv, cst[k]);
        }
      }
    }
#pragma unroll
    for (int k = 0; k < 3; ++k)
      { const int vt_ = (k < 2) ? (vbase + k) : 4; *(uint2*)(Cs + (vt_ * 16 + l15) * 72 + dkt * 16 + quad * 4) = pack4(cst[k]); }
    m_in = m_new;
  }
#undef ML_FETCH
#undef ML_FETCH1
  __syncthreads();
}

__device__ void gnorm_phase(const Params& p, int layer) {
  const int lane = tidx() & 63, wave = __builtin_amdgcn_readfirstlane(tidx() >> 6);
  const int e = layer >> 1;
  const bf16_t* Y0 = (const bf16_t*)(p.ws + OFF_Y);
  const bf16_t* Y1 = Y0 + (size_t)R * 512;
  const bf16_t* U = (const bf16_t*)(p.ws + OFF_UE);
  bf16_t* cat = (bf16_t*)((char*)p.out);
  const int nwv = gridDim.x * 8;
  const int c0 = lane * 8;
  float nwt[8];
#pragma unroll
  for (int i = 0; i < 8; ++i) nwt[i] = p.ev_ssm_norm_w[e * 512 + c0 + i];
  for (int r0 = bidx() * 8 + wave; r0 < R; r0 += nwv * 3) {
    uint4 a0[3], a1[3], az[3];
#pragma unroll
    for (int u = 0; u < 3; ++u) {
      const int r = r0 + u * nwv;
      if (r < R) {
        a0[u] = *(const uint4*)(Y0 + (size_t)r * 512 + c0);
        a1[u] = *(const uint4*)(Y1 + (size_t)r * 512 + c0);
        az[u] = *(const uint4*)(U + (size_t)r * 2304 + 544 + c0);
      }
    }
#pragma unroll
    for (int u = 0; u < 3; ++u) {
      const int r = r0 + u * nwv;
      if (r >= R) continue;
      float y0[8], y1[8], z[8];
      unpack8(a0[u], y0); unpack8(a1[u], y1); unpack8(az[u], z);
      float gv[8]; float ss = 0.f;
#pragma unroll
      for (int i = 0; i < 8; ++i) { gv[i] = (y0[i] + y1[i]) * siluf(z[i]); ss += gv[i] * gv[i]; }
#pragma unroll
      for (int o = 16; o > 0; o >>= 1) ss += __shfl_xor(ss, o);
      const float rstd = rsqrtf(ss * (1.f / 256.f) + EPS);
#pragma unroll
      for (int i = 0; i < 8; ++i) gv[i] = gv[i] * rstd * nwt[i];
      *(uint4*)(cat + (size_t)r * DM + 512 + c0) = packf8(gv);
    }
  }
}

__device__ void finish_phase(const Params& p, int layer) {
  const int lane = tidx() & 63, wave = __builtin_amdgcn_readfirstlane(tidx() >> 6);
  const int o_ = layer >> 1;
  const bf16_t* H0 = (const bf16_t*)(p.ws + OFF_HB);
  const bf16_t* H1 = H0 + (size_t)R * 1024;
  const bf16_t* U = (const bf16_t*)(p.ws + OFF_UO);
  bf16_t* cat = (bf16_t*)((char*)p.out);
  const int nwv = gridDim.x * 8;
  const int c0 = lane * 16;
  const float* nw = p.od_head_norm_w + o_ * 1024 + c0;
  for (int r0 = bidx() * 8 + wave; r0 < R; r0 += nwv * 3) {
    uint4 q0[3][2], q1[3][2], qg[3][2];
#pragma unroll
    for (int u = 0; u < 3; ++u) {
      const int r = r0 + u * nwv;
      if (r < R) {
#pragma unroll
        for (int k = 0; k < 2; ++k) {
          q0[u][k] = *(const uint4*)(H0 + (size_t)r * 1024 + c0 + k * 8);
          q1[u][k] = *(const uint4*)(H1 + (size_t)r * 1024 + c0 + k * 8);
          qg[u][k] = *(const uint4*)(U + (size_t)r * 2048 + 1024 + c0 + k * 8);
        }
      }
    }
#pragma unroll
    for (int u = 0; u < 3; ++u) {
      const int r = r0 + u * nwv;
      if (r >= R) continue;
      float h[16], t[16], og[16];
      unpack8(q0[u][0], h); unpack8(q0[u][1], h + 8);
      unpack8(q1[u][0], t); unpack8(q1[u][1], t + 8);
      unpack8(qg[u][0], og); unpack8(qg[u][1], og + 8);
      float ss = 0.f;
#pragma unroll
      for (int i = 0; i < 16; ++i) { h[i] += t[i]; ss += h[i] * h[i]; }
      ss += __shfl_xor(ss, 1); ss += __shfl_xor(ss, 2); ss += __shfl_xor(ss, 4);
      const float rstd = rsqrtf(ss * (1.f / 128.f) + EPS);
#pragma unroll
      for (int i = 0; i < 16; ++i) h[i] = sigmoidf(og[i]) * h[i] * rstd * nw[i];
      *(uint4*)(cat + (size_t)r * DM + c0) = packf8(h);
      *(uint4*)(cat + (size_t)r * DM + c0 + 8) = packf8(h + 8);
    }
  }
}

#define XB_TMO      128
#define XB_XCNT(j)  (256  + 64 * (j))
#define XB_XSUB(j)  (1280 + 64 * (j))
#define XB_XGEN(j)  (2304 + 64 * (j))
#define XB_TOP      3328
#define XB_TOPGEN   3392
#define XCD_BAR_WORDS 3456
#define XB_SPIN_CAP (1u << 20)
#define LAS __attribute__((address_space(3)))
__device__ __forceinline__ unsigned xb_ld(unsigned* p)              { return __hip_atomic_load(p, __ATOMIC_RELAXED, __HIP_MEMORY_SCOPE_AGENT); }
__device__ __forceinline__ unsigned xb_add(unsigned* p, unsigned v) { return __hip_atomic_fetch_add(p, v, __ATOMIC_RELAXED, __HIP_MEMORY_SCOPE_AGENT); }
__device__ __forceinline__ unsigned xb_xcc_id() { return (unsigned)__builtin_amdgcn_s_getreg((3 << 11) | 20) & 0xFu; }
#define XB_SPIN(cond, bar) do { unsigned _sp = 0; while (cond) { __builtin_amdgcn_s_sleep(1); \
    if ((++_sp & 255u) == 0u) { if (xb_ld(&(bar)[XB_TMO])) break; if (_sp > XB_SPIN_CAP) { atomicAdd(&(bar)[XB_TMO], 1u); break; } } } } while (0)
struct XcdBarrier { unsigned* bar; unsigned x; volatile LAS unsigned* st; };
__device__ __forceinline__ XcdBarrier xcd_barrier_post(unsigned* bar, volatile LAS unsigned* st) {
  XcdBarrier b; b.bar = bar; b.x = xb_xcc_id(); b.st = st;
  if (threadIdx.x == 0) (void)xb_add(&bar[XB_XCNT(b.x)], 1u);
  return b;
}
__device__ __forceinline__ void xcd_barrier_complete(unsigned* bar, unsigned x, unsigned& nloc, unsigned& nx) {
  const unsigned G = gridDim.x * gridDim.y * gridDim.z;
  unsigned sum, cnt, mine, sp = 0u;
  for (;;) {
    sum = 0u; cnt = 0u; mine = 0u;
#pragma unroll
    for (unsigned j = 0; j < 16; ++j) { const unsigned c = xb_ld(&bar[XB_XCNT(j)]); sum += c; cnt += (c > 0u) ? 1u : 0u; mine = (j == x) ? c : mine; }
    if (sum == G) break;
    __builtin_amdgcn_s_sleep(1);
    if ((++sp & 255u) == 0u) { if (xb_ld(&bar[XB_TMO])) break; if (sp > XB_SPIN_CAP) { atomicAdd(&bar[XB_TMO], 1u); break; } }
  }
  nloc = mine > 0u ? mine : 1u; nx = cnt > 0u ? cnt : 1u;
}
__device__ __forceinline__ void xcd_barrier(const XcdBarrier& b) {
  asm volatile("s_waitcnt vmcnt(0)" ::: "memory");
  __syncthreads();
  if (threadIdx.x == 0) {
    unsigned* bar = b.bar;
    __builtin_amdgcn_s_waitcnt(0);
    unsigned nloc = b.st[0], nx = b.st[1];
    if (nloc == 0u) { xcd_barrier_complete(bar, b.x, nloc, nx); b.st[0] = nloc; b.st[1] = nx; }
    const unsigned old = xb_add(&bar[XB_XSUB(b.x)], 1u);
    const unsigned gen = old / nloc;
    if (old + 1u == (gen + 1u) * nloc) {
      __builtin_amdgcn_fence(__ATOMIC_RELEASE, "agent");
      asm volatile("s_waitcnt vmcnt(0)" ::: "memory");
      const unsigned og = xb_add(&bar[XB_TOP], 1u);
      const unsigned tg = og / nx;
      if (og + 1u == (tg + 1u) * nx) xb_add(&bar[XB_TOPGEN], 1u);
      else XB_SPIN(xb_ld(&bar[XB_TOPGEN]) == tg, bar);
      __builtin_amdgcn_fence(__ATOMIC_ACQUIRE, "agent");
      xb_add(&bar[XB_XGEN(b.x)], 1u);
      asm volatile("s_waitcnt vmcnt(0)" ::: "memory");
    } else {
      XB_SPIN(xb_ld(&bar[XB_XGEN(b.x)]) == gen, bar);
      __builtin_amdgcn_fence(__ATOMIC_ACQUIRE, "agent");
      asm volatile("s_waitcnt vmcnt(0)" ::: "memory");
    }
  }
  __syncthreads();
}

__device__ void run_phase(const Params& p, int ph, char* smem) {
  if (ph == 0) { if (PHMASK & (1u << 13)) setup_phase(p, smem); return; }
  if (ph == NPH - 1) { if (PHMASK & (1u << 14)) final_phase(p); return; }
  const int q = ph - 1;
  const int pair = q / 19, rem = q - pair * 19;
  const bool even = rem < 10;
  const int layer = pair * 2 + (even ? 0 : 1);
  int st = even ? rem : rem - 10;
  const bool last = (layer == 3);
  const int li = layer >> 1;
  if (!even && st >= 3) st += 1;
  GemmDesc g, g2;
  g.layer = layer; g.gate_off = 0; g.skip_ctx = 0; g.A = nullptr; g.W = nullptr; g.lda = 1024; g.K = 1024; g.ntn = 0; g.epi = 0;
  g2 = g;
  int ntn2 = 0;
  bool is_gemm = false;
  switch (st) {
    case 0: if (PHMASK & 1u) norm_phase(p, layer, 0, false); break;
    case 1:
      is_gemm = true;
      g.A = (const bf16_t*)((char*)p.out);
      if (even) { g.W = (const bf16_t*)(p.ws + OFF_EVIN + li * SZ_EVIN); g.ntn = 9; g.epi = EPI_U_EVEN; }
      else { g.W = (const bf16_t*)(p.ws + OFF_ODIN + li * SZ_ODIN); g.ntn = 13; g.epi = EPI_U_ODD; }
      break;
    case 2: if (PHMASK & 4u) conv_phase(p, layer, even, smem); break;
    case 3:
      is_gemm = true;
      g.lda = 2304; g.K = 256; g.A = (const bf16_t*)(p.ws + OFF_UE); g.W = (const bf16_t*)(p.ws + OFF_UQ + li * SZ_UQ); g.epi = EPI_Q; g.ntn = 3;
      g2 = g; g2.A = (const bf16_t*)(p.ws + OFF_UE) + 256; g2.W = (const bf16_t*)(p.ws + OFF_UKV + li * SZ_UKV); g2.epi = EPI_KV; ntn2 = 4;
      break;
    case 4:
      if (even) {
        const int G_ = gridDim.x, bi = bidx();
        const bool bal = (G_ == 256);
        const int nit = bal ? (bi < 64 ? 2 : (bi < 128 ? 1 : 4)) : ((704 - bi + G_ - 1) / G_);
        for (int it = 0; it < nit; ++it) {
          int kind, ta, tb, tc;
          if (bal) {
            if (bi < 128) { if (it == 0) { kind = 0; ta = bi >> 4; tb = (bi >> 3) & 1; tc = bi & 7; } else { kind = 1; ta = bi >> 3; tb = bi & 7; tc = 8; } }
            else { const int j = bi - 128, xcd = j & 7, slot = j >> 3; const int bh = it * 16 + 2 * xcd + (slot >> 3); kind = 1; ta = bh >> 3; tb = bh & 7; tc = slot & 7; }
          } else {
            const int t = bi + it * G_;
            if (t < 128) { kind = 0; ta = t >> 4; tb = (t >> 3) & 1; tc = t & 7; }
            else { const int u = t - 128, bh = u / 9; kind = 1; ta = bh >> 3; tb = bh & 7; tc = u % 9; }
          }
          if (kind == 0) { if (PHMASK & (1u << 11)) ssd_tile(p, li, ta, tb, tc, smem); }
          else { if (PHMASK & (1u << 12)) attn_tile(p, ta, tb, tc, smem); }
        }
      } else {
        if (PHMASK & (1u << 10)) for (int t = bidx(); t < 256; t += gridDim.x) { int b = t >> 5, d = (t >> 4) & 1, hh = (t >> 1) & 7, vh = t & 1; mlstm_tile(p, li, b, d, hh, vh, smem); }
      }
      break;
    case 5: if (PHMASK & 32u) { if (even) gnorm_phase(p, layer); else finish_phase(p, layer); } break;
    case 6:
      is_gemm = true;
      g.A = (const bf16_t*)((char*)p.out); g.ntn = 4; g.epi = EPI_RESID; g.gate_off = 2048; g.skip_ctx = last;
      g.W = (const bf16_t*)(p.ws + (even ? OFF_EVOUT : OFF_ODOUT) + li * SZ_OUT);
      break;
    case 7: if (PHMASK & 1u) norm_phase(p, layer, 1, last); break;
    case 8:
      is_gemm = true;
      g.A = (const bf16_t*)((char*)p.out); g.ntn = 16; g.epi = EPI_SQRELU; g.skip_ctx = last;
      g.W = (const bf16_t*)(p.ws + OFF_W1 + layer * SZ_W1);
      break;
    case 9:
      is_gemm = true;
      g.A = (const bf16_t*)(p.ws + OFF_S); g.lda = 4096; g.K = 4096; g.ntn = 4; g.epi = EPI_RESID; g.gate_off = 5120; g.skip_ctx = last;
      g.W = (const bf16_t*)(p.ws + OFF_W2 + layer * SZ_W2);
      break;
  }
  if ((PHMASK & 2u) && is_gemm) {
    const int ntn = g.ntn + ntn2;
    const int nrt = (g.epi == EPI_RESID) ? 9 : (((g.epi == EPI_SQRELU && !g.skip_ctx) || g.epi == EPI_U_ODD) ? 12 : 16);
    const int per_b = LB / (nrt * 16);
    const int Tm = R / (nrt * 16);
    const int total = Tm * ntn;
    const int nig = 8 * ntn;
    const int nxb = gridDim.x >> 3;
    const int bi = bidx();
    const int spos = (bi & 7) * nxb + (bi >> 3);
    auto advance = [&](int& t0_, int& mt_, int& nt_) -> bool {
      while (true) {
        const int sidx = t0_ + spos;
        t0_ += gridDim.x;
        if (sidx >= total) return false;
        const int gid = sidx / nig, rem = sidx - gid * nig;
        const int fm = gid * 8;
        const int gsz = (Tm - fm) < 8 ? (Tm - fm) : 8;
        mt_ = fm + rem % gsz; nt_ = rem / gsz;
        if (g.skip_ctx && (mt_ % per_b) == per_b - 1) continue;
        return true;
      }
    };
    int t0 = 0, mt = 0, nt = 0;
    bool have = advance(t0, mt, nt);
    bool first = true;
    while (have) {
      int t0n = t0, mtn = 0, ntn_ = 0;
      const bool hn = advance(t0n, mtn, ntn_);
      GemmDesc h = g;
      int ntl = nt;
      if (nt >= g.ntn) { h.A = g2.A; h.W = g2.W; h.epi = g2.epi; ntl = nt - g.ntn; }
      const bf16_t* An = (ntn_ >= g.ntn) ? g2.A : g.A;
      const bf16_t* Wn = (ntn_ >= g.ntn) ? g2.W : g.W;
      const int ntnl = (ntn_ >= g.ntn) ? ntn_ - g.ntn : ntn_;
      An += (size_t)(mtn * nrt * 16) * g.lda;
      Wn += (size_t)(ntnl * 256) * g.K;
      gemm_tile(p, h, mt, ntl, smem, nrt, An, Wn, hn, first);
      first = false; have = hn; t0 = t0n; mt = mtn; nt = ntn_;
    }
  }
}

__global__ void __launch_bounds__(NT) mega(Params p) {
  extern __shared__ __attribute__((aligned(1024))) char smem[];
  volatile LAS unsigned* st = (volatile LAS unsigned*)(smem + LDS_PHASE);
  if (threadIdx.x == 0) { st[0] = 0u; st[1] = 0u; }
  __syncthreads();
  XcdBarrier xb = xcd_barrier_post((unsigned*)(p.ws + OFF_BAR), st);
  for (int ph = p.ph_begin; ph < p.ph_end; ++ph) {
    run_phase(p, ph, smem);
    if (p.coop && ph + 1 < p.ph_end) {
      if (ph == 0) cg::this_grid().sync();
      else xcd_barrier(xb);
    }
  }
}

__global__ void __launch_bounds__(256) dump_bf16(const bf16_t* src, float* dst, size_t n) {
  for (size_t i = (size_t)blockIdx.x * 256 + threadIdx.x; i < n; i += (size_t)gridDim.x * 256) dst[i] = __uint_as_float(((unsigned)src[i]) << 16);
}
__global__ void __launch_bounds__(256) dump_f32(const float* src, float* dst, size_t n) {
  for (size_t i = (size_t)blockIdx.x * 256 + threadIdx.x; i < n; i += (size_t)gridDim.x * 256) dst[i] = src[i];
}

extern "C" void kernel_launch(void* const* d_in, const int* in_sizes, int n_in, void* d_out, int out_size, void* d_ws, size_t ws_size, hipStream_t stream) {
  (void)in_sizes; (void)n_in; (void)out_size;
  if (ws_size < WS_TOTAL) { fprintf(stderr, "workspace too small: %zu < %zu\n", ws_size, (size_t)WS_NEED); return; }
  Params p;
  memset(&p, 0, sizeof(p));
  const float** fp = (const float**)&p.x;
  for (int i = 0; i < 30; ++i) fp[i] = (const float*)d_in[i];
  p.out = (float*)d_out; p.ws = (char*)d_ws;
#ifdef DBG_MEMSET
  (void)hipMemsetAsync((char*)d_ws + DBG_MS_OFF, 0, DBG_MS_LEN, stream);
#endif
  static bool attr_set = false;
  if (!attr_set) { (void)hipFuncSetAttribute((const void*)mega, hipFuncAttributeMaxDynamicSharedMemorySize, LDS_BYTES); attr_set = true; }
#if SINGLE_LAUNCH
  static int grid_blocks = 0;
  if (!grid_blocks) {
    int dev = 0, cus = 0, per_cu = 0;
    hipGetDevice(&dev);
    hipDeviceGetAttribute(&cus, hipDeviceAttributeMultiprocessorCount, dev);
    hipOccupancyMaxActiveBlocksPerMultiprocessor(&per_cu, mega, NT, LDS_BYTES);
    if (per_cu > 1) per_cu = 1;
    grid_blocks = cus * per_cu;
  }
  (void)hipMemsetAsync((char*)d_ws + OFF_BAR, 0, 16384, stream);
  p.ph_begin = 0; p.ph_end = NPH; p.coop = 1;
  void* args[] = {&p};
  hipError_t e = hipLaunchCooperativeKernel((void*)mega, dim3(grid_blocks), dim3(NT), args, LDS_BYTES, stream);
  if (e != hipSuccess) fprintf(stderr, "cooperative launch failed: %s (grid %d)\n", hipGetErrorString(e), grid_blocks);
#else
  for (int ph = 0; ph < NPH; ++ph) {
    if (ph >= 1 && ph < NPH - 1) { int q_ = ph - 1; int pr_ = q_ / 19, rm_ = q_ % 19; int ly_ = pr_ * 2 + (rm_ < 10 ? 0 : 1); if (!((DBG_LAYERS >> ly_) & 1)) continue; }
#ifdef DBG_STOP_PH
    if (ph > DBG_STOP_PH) continue;
#endif
    p.ph_begin = ph; p.ph_end = ph + 1; p.coop = 0;
    hipLaunchKernelGGL(mega, dim3(256), dim3(NT), LDS_BYTES, stream, p);
  }
#ifdef DBG_STOP_PH
#if DBG_DUMP_F32
  hipLaunchKernelGGL(dump_f32, dim3(2048), dim3(256), 0, stream, (const float*)((char*)d_ws + DBG_DUMP_OFF), (float*)d_out, (size_t)DBG_DUMP_N);
#else
  hipLaunchKernelGGL(dump_bf16, dim3(2048), dim3(256), 0, stream, (const bf16_t*)((char*)d_ws + DBG_DUMP_OFF), (float*)d_out, (size_t)DBG_DUMP_N);
#endif
#endif
#endif
}
```

```cpp
#include <hip/hip_runtime.h>
#include <hip/hip_cooperative_groups.h>
#include <cstdio>
#include <cstdint>
#include <cstring>
namespace cg = cooperative_groups;

#ifndef PHMASK
#define PHMASK 0xFFFFu
#endif
#ifndef DBG_LAYERS
#define DBG_LAYERS 0xF
#endif
#define DBG_NOSTATE 0
#define DBG_DUMP_OFF OFF_HB
#define DBG_DUMP_N ((size_t)8*2048*1024)
#define DBG_DUMP_F32 0
#ifndef RESID_MI
#define RESID_MI 6
#endif
#ifndef SINGLE_LAUNCH
#define SINGLE_LAUNCH 1
#endif

typedef unsigned short bf16_t;
typedef short bf16x8 __attribute__((ext_vector_type(8)));
typedef short bf16x4 __attribute__((ext_vector_type(4)));
typedef float f32x4 __attribute__((ext_vector_type(4)));

constexpr int NT = 512;
constexpr int DM = 1024;
constexpr int NB = 8;
constexpr int LB = 2304;
constexpr int R = NB * LB;
constexpr int NPH = 40;
constexpr float EPS = 1e-6f;
constexpr int LDS_PHASE = 141312;
constexpr int LDS_BYTES = LDS_PHASE + 16;

constexpr size_t SZ_W1 = (size_t)4096 * 1024 * 2, SZ_W2 = SZ_W1;
constexpr size_t SZ_EVIN = (size_t)2304 * 1024 * 2, SZ_UQ = (size_t)768 * 256 * 2, SZ_UKV = (size_t)1024 * 256 * 2, SZ_OUT = (size_t)1024 * 1024 * 2;
constexpr size_t SZ_ODIN = (size_t)3328 * 1024 * 2;
constexpr size_t OFF_W1 = 0;
constexpr size_t OFF_W2 = OFF_W1 + 4 * SZ_W1;
constexpr size_t OFF_EVIN = OFF_W2 + 4 * SZ_W2;
constexpr size_t OFF_UQ = OFF_EVIN + 2 * SZ_EVIN;
constexpr size_t OFF_UKV = OFF_UQ + 2 * SZ_UQ;
constexpr size_t OFF_EVOUT = OFF_UKV + 2 * SZ_UKV;
constexpr size_t OFF_ODIN = OFF_EVOUT + 2 * SZ_OUT;
constexpr size_t OFF_ODOUT = OFF_ODIN + 2 * SZ_ODIN;
constexpr size_t OFF_MOD = OFF_ODOUT + 2 * SZ_OUT;
constexpr size_t OFF_XCTX = OFF_MOD + (size_t)4 * 9 * 6144 * 4;
constexpr size_t OFF_H = OFF_XCTX + (size_t)2048 * 1024 * 4;
constexpr size_t OFF_XB = OFF_H;
constexpr size_t OFF_S = OFF_H + (size_t)R * 1024 * 2;
constexpr size_t SZ_S = (size_t)R * 4096 * 2;
constexpr size_t OFF_GATES = OFF_S + SZ_S;
constexpr size_t OFF_M = OFF_GATES + (size_t)R * 32 * 4;
constexpr size_t OFF_UE = OFF_S;
constexpr size_t OFF_Y = OFF_UE + (size_t)R * 2304 * 2;
constexpr size_t OFF_Q = OFF_Y + (size_t)2 * R * 512 * 2;
static_assert(OFF_Q + (size_t)R * 768 * 2 <= OFF_S + SZ_S, "S overflow even");
constexpr size_t OFF_KN = OFF_M;
constexpr size_t OFF_KR = OFF_KN + (size_t)R * 512 * 2;
constexpr size_t OFF_VTE = OFF_KR + (size_t)R * 32 * 2;
constexpr size_t OFF_XT = OFF_VTE + (size_t)R * 512 * 2;
constexpr size_t OFF_BM = OFF_XT + (size_t)R * 512 * 2;
constexpr size_t OFF_BMT = OFF_BM + (size_t)R * 256 * 2;
constexpr size_t OFF_CM = OFF_BMT + (size_t)R * 256 * 2;
constexpr size_t OFF_DT = OFF_CM + (size_t)R * 256 * 2;
constexpr size_t OFF_DA = OFF_DT + (size_t)R * 16 * 4;
constexpr size_t END_EVEN = OFF_DA + (size_t)R * 16 * 4;
constexpr size_t OFF_UO = OFF_S;
constexpr size_t OFF_HB = OFF_UO + (size_t)R * 2048 * 2;
static_assert(OFF_HB + (size_t)2 * R * 1024 * 2 <= OFF_S + SZ_S, "S overflow odd");
constexpr size_t OFF_QC = OFF_M;
constexpr size_t OFF_KC = OFF_QC + (size_t)R * 512 * 2;
constexpr size_t OFF_KT = OFF_KC + (size_t)R * 512 * 2;
constexpr size_t OFF_VTO = OFF_KT + (size_t)R * 512 * 2;
constexpr size_t END_ODD = OFF_VTO + (size_t)R * 1024 * 2;
constexpr size_t WS_NEED = END_ODD > END_EVEN ? END_ODD : END_EVEN;
constexpr size_t OFF_BAR = (WS_NEED + 255) / 256 * 256;
constexpr size_t WS_TOTAL = OFF_BAR + 16384;
static_assert(WS_TOTAL <= (size_t)402000000, "workspace too large");

struct WDesc { const float* src; bf16_t* dst; int K, N, Npad, tstart; };

struct Params {
  const float *x, *c, *ctx, *c_ctx, *ada_w, *ada_b, *norm_mix_w, *norm_mlp_w, *mlp_w1, *mlp_w2;
  const float *ev_w_in, *ev_q_norm_w, *ev_w_uq, *ev_kv_norm_w, *ev_w_ukv, *ev_conv_w, *ev_conv_b, *ev_dt_bias, *ev_a_log, *ev_d_skip, *ev_ssm_norm_w, *ev_w_out;
  const float *od_w_in, *od_conv_w, *od_conv_b, *od_i_bias, *od_f_bias, *od_head_norm_w, *od_w_out, *final_norm_w;
  float* out; char* ws;
  int ph_begin, ph_end, coop, pad0;
};

__device__ __forceinline__ int tidx() { int t = threadIdx.x; asm volatile("" : "+v"(t)); return t; }
__device__ __forceinline__ int bidx() { int t = blockIdx.x; asm volatile("" : "+s"(t)); return t; }
__device__ __forceinline__ unsigned short f2bf(float f) {
  unsigned u = __float_as_uint(f);
  u += 0x7fffu + ((u >> 16) & 1u);
  return (unsigned short)(u >> 16);
}
__device__ __forceinline__ float bf2f(unsigned short h) { return __uint_as_float(((unsigned)h) << 16); }
__device__ __forceinline__ unsigned pack2(float a, float b) { unsigned r; asm("v_cvt_pk_bf16_f32 %0, %1, %2" : "=v"(r) : "v"(a), "v"(b)); return r; }
__device__ __forceinline__ uint2 pack4(f32x4 v) { return make_uint2(pack2(v[0], v[1]), pack2(v[2], v[3])); }
__device__ __forceinline__ bf16x8 pack8(f32x4 a, f32x4 b) {
  union { bf16x8 v; unsigned u[4]; } r;
  r.u[0] = pack2(a[0], a[1]); r.u[1] = pack2(a[2], a[3]); r.u[2] = pack2(b[0], b[1]); r.u[3] = pack2(b[2], b[3]);
  return r.v;
}
__device__ __forceinline__ bf16x8 cat44(uint2 a, uint2 b) {
  union { bf16x8 v; unsigned u[4]; } r;
  r.u[0] = a.x; r.u[1] = a.y; r.u[2] = b.x; r.u[3] = b.y;
  return r.v;
}
__device__ __forceinline__ f32x4 mfma16(bf16x8 a, bf16x8 b, f32x4 c) { return __builtin_amdgcn_mfma_f32_16x16x32_bf16(a, b, c, 0, 0, 0); }
__device__ __forceinline__ float wave_sum(float v) {
#pragma unroll
  for (int o = 32; o > 0; o >>= 1) v += __shfl_xor(v, o);
  return v;
}
__device__ __forceinline__ float scan_add(float v, int lane) {
#pragma unroll
  for (int o = 1; o < 64; o <<= 1) { float t = __shfl_up(v, o); if (lane >= o) v += t; }
  return v;
}
__device__ __forceinline__ float scan_max(float v, int lane) {
#pragma unroll
  for (int o = 1; o < 64; o <<= 1) { float t = __shfl_up(v, o); if (lane >= o) v = fmaxf(v, t); }
  return v;
}
__device__ __forceinline__ float siluf(float v) { return v * __builtin_amdgcn_rcpf(1.f + __expf(-v)); }
__device__ __forceinline__ float sigmoidf(float v) { return __builtin_amdgcn_rcpf(1.f + __expf(-v)); }
__device__ __forceinline__ float softplusf(float v) { return fmaxf(v, 0.f) + __logf(1.f + __expf(-fabsf(v))); }
__device__ __forceinline__ float* xrow(const Params& p, int r) {
  int b = r / LB, s = r - b * LB;
  return s < 2048 ? p.out + (size_t)(b * 2048 + s) * DM : (float*)(p.ws + OFF_XCTX) + (size_t)(b * 256 + (s - 2048)) * DM;
}
__device__ __forceinline__ void rope8(const float* own, const float* par, float pos, bool hi, float* o) {
  const float inv[8] = {1.f, 0.316227766f, 0.1f, 0.0316227766f, 0.01f, 0.00316227766f, 0.001f, 0.000316227766f};
#pragma unroll
  for (int i = 0; i < 8; ++i) {
    float ang = pos * inv[i];
    float k = rintf(ang * 0.15915494309f);
    ang = ang - k * 6.28318530718f;
    float sn = __sinf(ang), cs = __cosf(ang);
    o[i] = hi ? own[i] * cs + par[i] * sn : own[i] * cs - par[i] * sn;
  }
}
__device__ __forceinline__ void unpack8(uint4 v, float* f) {
  f[0] = __uint_as_float(v.x << 16); f[1] = __uint_as_float(v.x & 0xffff0000u);
  f[2] = __uint_as_float(v.y << 16); f[3] = __uint_as_float(v.y & 0xffff0000u);
  f[4] = __uint_as_float(v.z << 16); f[5] = __uint_as_float(v.z & 0xffff0000u);
  f[6] = __uint_as_float(v.w << 16); f[7] = __uint_as_float(v.w & 0xffff0000u);
}
__device__ __forceinline__ uint4 packf8(const float* f) {
  return make_uint4(pack2(f[0], f[1]), pack2(f[2], f[3]), pack2(f[4], f[5]), pack2(f[6], f[7]));
}

__device__ void wt_tile_wave(const WDesc w, int t) {
  const int lane = tidx() & 63;
  const int nkt = w.K >> 6;
  const int ntile = t / nkt, ktile = t - ntile * nkt;
  const int kb = lane & 7, nb = lane >> 3;
  const int k0 = ktile * 64 + kb * 8, n0 = ntile * 64 + nb * 8;
  float v[8][8];
  if (n0 + 8 <= w.N) {
#pragma unroll
    for (int kk = 0; kk < 8; ++kk) {
      const float* src = w.src + (size_t)(k0 + kk) * w.N + n0;
      float4 a = *(const float4*)src, b = *(const float4*)(src + 4);
      v[kk][0] = a.x; v[kk][1] = a.y; v[kk][2] = a.z; v[kk][3] = a.w; v[kk][4] = b.x; v[kk][5] = b.y; v[kk][6] = b.z; v[kk][7] = b.w;
    }
  } else {
#pragma unroll
    for (int kk = 0; kk < 8; ++kk)
#pragma unroll
      for (int e = 0; e < 8; ++e) v[kk][e] = 0.f;
  }
#pragma unroll
  for (int e = 0; e < 8; ++e) {
    uint4 o = make_uint4(pack2(v[0][e], v[1][e]), pack2(v[2][e], v[3][e]), pack2(v[4][e], v[5][e]), pack2(v[6][e], v[7][e]));
    *(uint4*)(w.dst + (size_t)(n0 + e) * w.K + k0) = o;
  }
}

__device__ void ada_tile(const Params& p, int t, char* smem) {
  const int tid = tidx(), lane = tid & 63, wave = __builtin_amdgcn_readfirstlane(tid >> 6);
  const int l = t / 192, cgp = t - l * 192;
  float* sv = (float*)smem;
  float* red = sv + 9 * 1024;
  for (int idx = tid; idx < 9 * 1024; idx += NT) {
    int r = idx >> 10, k = idx & 1023;
    float v = r < 8 ? p.c[r * 1024 + k] : p.c_ctx[k];
    sv[idx] = siluf(v);
  }
  __syncthreads();
  const int cl = lane & 7, rg = lane >> 3;
  const float* wp = p.ada_w + (size_t)l * 1024 * 6144 + cgp * 32 + cl * 4;
  const int kb = wave * 128 + rg;
  float4 wv[16];
#pragma unroll
  for (int it = 0; it < 16; ++it) wv[it] = *(const float4*)(wp + (size_t)(kb + it * 8) * 6144);
  float acc[9][4];
#pragma unroll
  for (int r = 0; r < 9; ++r) { acc[r][0] = 0.f; acc[r][1] = 0.f; acc[r][2] = 0.f; acc[r][3] = 0.f; }
#pragma unroll
  for (int it = 0; it < 16; ++it) {
    const int k = kb + it * 8;
#pragma unroll
    for (int r = 0; r < 9; ++r) {
      const float sx = sv[r * 1024 + k];
      acc[r][0] += sx * wv[it].x; acc[r][1] += sx * wv[it].y; acc[r][2] += sx * wv[it].z; acc[r][3] += sx * wv[it].w;
    }
  }
#pragma unroll
  for (int r = 0; r < 9; ++r)
#pragma unroll
    for (int e = 0; e < 4; ++e) {
      float v = acc[r][e];
      v += __shfl_xor(v, 8); v += __shfl_xor(v, 16); v += __shfl_xor(v, 32);
      acc[r][e] = v;
    }
  if (rg == 0) {
#pragma unroll
    for (int r = 0; r < 9; ++r)
#pragma unroll
      for (int e = 0; e < 4; ++e) red[(wave * 9 + r) * 32 + cl * 4 + e] = acc[r][e];
  }
  __syncthreads();
  float* mod = (float*)(p.ws + OFF_MOD);
  if (tid < 9 * 32) {
    int r = tid >> 5, cc = tid & 31;
    float sacc = 0.f;
#pragma unroll
    for (int w = 0; w < 8; ++w) sacc += red[(w * 9 + r) * 32 + cc];
    mod[((size_t)l * 9 + r) * 6144 + cgp * 32 + cc] = sacc + p.ada_b[l * 6144 + cgp * 32 + cc];
  }
  __syncthreads();
}

__device__ __forceinline__ bool wsel(int& tt, int cnt, int per, int& idx) {
  if (tt < cnt * per) { idx = tt / per; tt -= idx * per; return true; }
  tt -= cnt * per; return false;
}
constexpr int N_WTILES = 4 * 1024 + 4 * 1024 + 2 * (576 + 48 + 64 + 256 + 832 + 256);
__device__ void setup_phase(const Params& p, char* smem) {
  for (int t = bidx(); t < 768; t += gridDim.x) ada_tile(p, t, smem);
  const int wave = __builtin_amdgcn_readfirstlane(tidx() >> 6);
  for (int t = bidx() * 8 + wave; t < N_WTILES; t += gridDim.x * 8) {
    int tt = t, i = 0;
    WDesc w; w.tstart = 0;
    if (wsel(tt, 4, 1024, i)) { w.src = p.mlp_w1 + (size_t)i * 1024 * 4096; w.dst = (bf16_t*)(p.ws + OFF_W1 + i * SZ_W1); w.K = 1024; w.N = 4096; }
    else if (wsel(tt, 4, 1024, i)) { w.src = p.mlp_w2 + (size_t)i * 1024 * 4096; w.dst = (bf16_t*)(p.ws + OFF_W2 + i * SZ_W2); w.K = 4096; w.N = 1024; }
    else if (wsel(tt, 2, 576, i)) { w.src = p.ev_w_in + (size_t)i * 1024 * 2096; w.dst = (bf16_t*)(p.ws + OFF_EVIN + i * SZ_EVIN); w.K = 1024; w.N = 2096; }
    else if (wsel(tt, 2, 48, i)) { w.src = p.ev_w_uq + (size_t)i * 256 * 768; w.dst = (bf16_t*)(p.ws + OFF_UQ + i * SZ_UQ); w.K = 256; w.N = 768; }
    else if (wsel(tt, 2, 64, i)) { w.src = p.ev_w_ukv + (size_t)i * 256 * 1024; w.dst = (bf16_t*)(p.ws + OFF_UKV + i * SZ_UKV); w.K = 256; w.N = 1024; }
    else if (wsel(tt, 2, 256, i)) { w.src = p.ev_w_out + (size_t)i * 1024 * 1024; w.dst = (bf16_t*)(p.ws + OFF_EVOUT + i * SZ_OUT); w.K = 1024; w.N = 1024; }
    else if (wsel(tt, 2, 832, i)) { w.src = p.od_w_in + (size_t)i * 1024 * 3104; w.dst = (bf16_t*)(p.ws + OFF_ODIN + i * SZ_ODIN); w.K = 1024; w.N = 3104; }
    else { wsel(tt, 2, 256, i); w.src = p.od_w_out + (size_t)i * 1024 * 1024; w.dst = (bf16_t*)(p.ws + OFF_ODOUT + i * SZ_OUT); w.K = 1024; w.N = 1024; }
    w.Npad = 0;
    wt_tile_wave(w, tt);
  }
  bf16_t* xbw = (bf16_t*)(p.ws + OFF_XB);
  for (size_t i = (size_t)bidx() * NT + tidx(); i < (size_t)R * DM / 8; i += (size_t)gridDim.x * NT) {
    const int r = (int)(i >> 7), c8 = (int)(i & 127) * 8;
    const int b = r / LB, sq = r - b * LB;
    const float* src = (sq < 2048 ? p.x + (size_t)(b * 2048 + sq) * DM : p.ctx + (size_t)(b * 256 + (sq - 2048)) * DM) + c8;
    const float4 f0 = *(const float4*)src, f1 = *(const float4*)(src + 4);
    *(uint4*)(xbw + (size_t)r * DM + c8) = make_uint4(pack2(f0.x, f0.y), pack2(f0.z, f0.w), pack2(f1.x, f1.y), pack2(f1.z, f1.w));
  }
}

__device__ void norm_phase(const Params& p, int layer, int which, bool skip_ctx) {
  const int lane = tidx() & 63, wave = __builtin_amdgcn_readfirstlane(tidx() >> 6);
  const float* w = (which ? p.norm_mlp_w : p.norm_mix_w) + layer * DM;
  const float* mod = (const float*)(p.ws + OFF_MOD) + (size_t)layer * 9 * 6144;
  bf16_t* h = (bf16_t*)((char*)p.out);
  const bf16_t* xb = (const bf16_t*)(p.ws + OFF_XB);
  const int c0 = lane * 16;
  float wr[16];
#pragma unroll
  for (int k = 0; k < 4; ++k) { float4 t = *(const float4*)(w + c0 + k * 4); wr[k * 4] = t.x; wr[k * 4 + 1] = t.y; wr[k * 4 + 2] = t.z; wr[k * 4 + 3] = t.w; }
  const int nwv = gridDim.x * 8;
  for (int r0 = bidx() * 8 + wave; r0 < R; r0 += nwv * 3) {
    uint4 q[3][2]; bool ok[3]; int mrr[3];
#pragma unroll
    for (int u = 0; u < 3; ++u) {
      const int r = r0 + u * nwv;
      const int b = r / LB, s = r - b * LB;
      ok[u] = (r < R) && !(skip_ctx && s >= 2048);
      mrr[u] = s < 2048 ? b : 8;
      if (ok[u]) { q[u][0] = *(const uint4*)(xb + (size_t)r * DM + c0); q[u][1] = *(const uint4*)(xb + (size_t)r * DM + c0 + 8); }
    }
#pragma unroll
    for (int u = 0; u < 3; ++u) {
      if (!ok[u]) continue;
      const int r = r0 + u * nwv;
      float f[16]; unpack8(q[u][0], f); unpack8(q[u][1], f + 8);
      float ss = 0.f;
#pragma unroll
      for (int k = 0; k < 16; ++k) ss += f[k] * f[k];
      ss = wave_sum(ss);
      const float rstd = rsqrtf(ss * (1.f / 1024.f) + EPS);
      const float* sh = mod + (size_t)mrr[u] * 6144 + (which ? 3072 : 0) + c0;
      const float* sc = sh + 1024;
#pragma unroll
      for (int k = 0; k < 4; ++k) {
        const float4 s4 = *(const float4*)(sh + k * 4), c4 = *(const float4*)(sc + k * 4);
        f[k * 4]     = f[k * 4]     * rstd * wr[k * 4]     * (1.f + c4.x) + s4.x;
        f[k * 4 + 1] = f[k * 4 + 1] * rstd * wr[k * 4 + 1] * (1.f + c4.y) + s4.y;
        f[k * 4 + 2] = f[k * 4 + 2] * rstd * wr[k * 4 + 2] * (1.f + c4.z) + s4.z;
        f[k * 4 + 3] = f[k * 4 + 3] * rstd * wr[k * 4 + 3] * (1.f + c4.w) + s4.w;
      }
      *(uint4*)(h + (size_t)r * DM + c0) = packf8(f);
      *(uint4*)(h + (size_t)r * DM + c0 + 8) = packf8(f + 8);
    }
  }
}

__device__ void final_phase(const Params& p) {
  const int lane = tidx() & 63, wave = __builtin_amdgcn_readfirstlane(tidx() >> 6);
  for (int r = bidx() * 8 + wave; r < NB * 2048; r += gridDim.x * 8) {
    const int b = r >> 11, t = r & 2047;
    const bf16_t* xr = (const bf16_t*)(p.ws + OFF_XB) + (size_t)(b * LB + t) * DM;
    float4 v[4]; float ss = 0.f;
    uint2 q_[4];
#pragma unroll
    for (int i = 0; i < 4; ++i) q_[i] = *(const uint2*)(xr + i * 256 + lane * 4);
#pragma unroll
    for (int i = 0; i < 4; ++i) {
      v[i].x = __uint_as_float(q_[i].x << 16); v[i].y = __uint_as_float(q_[i].x & 0xffff0000u);
      v[i].z = __uint_as_float(q_[i].y << 16); v[i].w = __uint_as_float(q_[i].y & 0xffff0000u);
      ss += v[i].x * v[i].x + v[i].y * v[i].y + v[i].z * v[i].z + v[i].w * v[i].w;
    }
    ss = wave_sum(ss);
    float rstd = rsqrtf(ss * (1.f / 1024.f) + EPS);
#pragma unroll
    for (int i = 0; i < 4; ++i) {
      int col = i * 256 + lane * 4;
      float4 w4 = *(const float4*)(p.final_norm_w + col);
      float4 o = make_float4(v[i].x * rstd * w4.x, v[i].y * rstd * w4.y, v[i].z * rstd * w4.z, v[i].w * rstd * w4.w);
      *(float4*)(p.out + (size_t)r * DM + col) = o;
    }
  }
}

enum { EPI_U_EVEN = 0, EPI_U_ODD, EPI_Q, EPI_KV, EPI_RESID, EPI_SQRELU };
struct GemmDesc { const bf16_t* A; int lda; const bf16_t* W; int K; int ntn; int epi; int layer; int gate_off; int skip_ctx; };

__device__ __forceinline__ int lds_byte2(int r, int c) {
  int st = (r >> 4) * 2 + (c >> 5), ob = (r & 15) * 64 + (c & 31) * 2;
  return st * 1024 + (ob ^ (((ob >> 9) & 1) << 5));
}
__device__ __forceinline__ void stage_rc2(int b, int& R, int& C) {
  int st = b >> 10, sb = b & 1023, swz = sb ^ (((sb >> 9) & 1) << 5);
  R = (st >> 1) * 16 + swz / 64;
  C = (st & 1) * 32 + (swz % 64) / 2;
}
#define GLDS16(gp, lp) __builtin_amdgcn_global_load_lds((const __attribute__((address_space(1))) unsigned*)(gp), (__attribute__((address_space(3))) unsigned*)(lp), 16, 0, 0)

__device__ void gemm_tile(const Params& p, const GemmDesc& g, int mt, int nt, char* smem, const int nrt,
                          const bf16_t* Ag_n, const bf16_t* Wg_n, const bool has_next, const bool first) {
  constexpr int MI = 8;
  const int BMR = nrt * 16;
  const int TA = BMR * 128;
  constexpr int TB = 256 * 128;
  const int STG = TA + TB;
  constexpr int GLB = TB / 8192;
  const int tid = tidx(), lane = tid & 63, wave = __builtin_amdgcn_readfirstlane(tid >> 6), l15 = lane & 15, quad = lane >> 4;
  const int wm = wave >> 2, wn = wave & 3;
  const int base_rt = wm * ((nrt + 1) >> 1);
  const int cnt = wm ? (nrt >> 1) : ((nrt + 1) >> 1);
  const int m0 = mt * BMR, n0 = nt * 256;
  const int K = g.K, lda = g.lda;
  const bf16_t* Ag = g.A + (size_t)m0 * lda;
  const bf16_t* Wg = g.W + (size_t)n0 * K;
  f32x4 acc[MI][4];
#pragma unroll
  for (int i = 0; i < MI; ++i)
#pragma unroll
    for (int j = 0; j < 4; ++j) acc[i][j] = (f32x4){0.f, 0.f, 0.f, 0.f};
  const int nk = K >> 6;
  const int nw = n0 + wn * 64;
  int R0, C0;
  stage_rc2(wave * 1024 + lane * 16, R0, C0);
  const int R0b = (R0 & ~31) + 8 * ((R0 & 15) >> 2) + 4 * ((R0 >> 4) & 1) + (R0 & 3);
  const int offA = R0 * lda + C0, offB = R0b * K + C0;
#define GSTAGE(A_, W_, buf, kt) do { \
    const bf16_t* ak_ = (A_) + (kt) * 64; const bf16_t* wk_ = (W_) + (kt) * 64; \
    _Pragma("unroll") for (int i_ = 0; i_ < GLB; ++i_) if (wave + 8 * i_ < 2 * nrt) GLDS16(ak_ + (size_t)(i_ * 64) * lda + offA, smem + (buf) * STG + wave * 1024 + i_ * 8192); \
    _Pragma("unroll") for (int i_ = 0; i_ < GLB; ++i_) GLDS16(wk_ + (size_t)(i_ * 64) * K + offB, smem + (buf) * STG + TA + wave * 1024 + i_ * 8192); } while (0)
  const int ob_ = l15 * 64 + quad * 16;
  const int lane_off = ob_ ^ (((ob_ >> 9) & 1) << 5);
  const int a_off = lane_off + base_rt * 2048;
  const int b_off = lane_off + TA + (wn * 4) * 2048;
#define LDA_LO(A_, base, ks) do { _Pragma("unroll") for (int i_ = 0; i_ < 4; ++i_) A_[i_] = *(const bf16x8*)((base) + a_off + (i_ * 2 + (ks)) * 1024); } while (0)
#define LDA_HI(A_, base, ks) do { if (cnt > 4) { A_[0] = *(const bf16x8*)((base) + a_off + (4 * 2 + (ks)) * 1024); \
    if (cnt > 5) { A_[1] = *(const bf16x8*)((base) + a_off + (5 * 2 + (ks)) * 1024); \
    if (cnt == 8) { _Pragma("unroll") for (int i_ = 6; i_ < 8; ++i_) A_[i_ - 4] = *(const bf16x8*)((base) + a_off + (i_ * 2 + (ks)) * 1024); } } } } while (0)
#define LDB_F(B_, base, ks) do { _Pragma("unroll") for (int j_ = 0; j_ < 4; ++j_) B_[j_] = *(const bf16x8*)((base) + b_off + (j_ * 2 + (ks)) * 1024); } while (0)
#define MMA_LO(A_, B_) do { _Pragma("unroll") for (int i_ = 0; i_ < 4; ++i_) { _Pragma("unroll") for (int j_ = 0; j_ < 4; ++j_) acc[i_][j_] = mfma16(B_[j_], A_[i_], acc[i_][j_]); } } while (0)
#define MMA_HI(A_, B_) do { if (cnt > 4) { _Pragma("unroll") for (int j_ = 0; j_ < 4; ++j_) acc[4][j_] = mfma16(B_[j_], A_[0], acc[4][j_]); \
    if (cnt > 5) { _Pragma("unroll") for (int j_ = 0; j_ < 4; ++j_) acc[5][j_] = mfma16(B_[j_], A_[1], acc[5][j_]); \
    if (cnt == 8) { _Pragma("unroll") for (int i_ = 6; i_ < 8; ++i_) { _Pragma("unroll") for (int j_ = 0; j_ < 4; ++j_) acc[i_][j_] = mfma16(B_[j_], A_[i_ - 4], acc[i_][j_]); } } } } } while (0)
#define SB_ __builtin_amdgcn_sched_barrier(0)
  bf16x8 aL[4], aH[4], bX[4], bY[4];
  if (first) GSTAGE(Ag, Wg, 0, 0);
  asm volatile("s_waitcnt vmcnt(0)" ::: "memory");
  __syncthreads();
  LDA_LO(aL, smem, 0); LDB_F(bX, smem, 0);
#pragma unroll 1
  for (int kt = 0; kt < nk; ++kt) {
    const int buf = kt & 1;
    const char* cur = smem + buf * STG;
    const char* nxt = smem + (buf ^ 1) * STG;
    if (kt + 1 < nk) GSTAGE(Ag, Wg, buf ^ 1, kt + 1);
    else if (has_next) GSTAGE(Ag_n, Wg_n, buf ^ 1, 0);
    LDA_HI(aH, cur, 0); SB_; MMA_LO(aL, bX); SB_;
    LDA_LO(aL, cur, 1); LDB_F(bY, cur, 1); SB_; MMA_HI(aH, bX); SB_;
    LDA_HI(aH, cur, 1); SB_; MMA_LO(aL, bY); SB_;
    asm volatile("s_waitcnt vmcnt(0)" ::: "memory");
    __syncthreads();
    if (kt + 1 < nk) { LDA_LO(aL, nxt, 0); LDB_F(bX, nxt, 0); }
    SB_; MMA_HI(aH, bY); SB_;
  }
#undef LDA_LO
#undef LDA_HI
#undef LDB_F
#undef MMA_LO
#undef MMA_HI
#undef SB_
#undef GSTAGE

  const float* mod = (const float*)(p.ws + OFF_MOD) + (size_t)g.layer * 9 * 6144;
#pragma unroll
  for (int i = 0; i < MI; ++i) {
    if (i >= cnt) break;
    const int m = m0 + (base_rt + i) * 16 + l15;
    const int bb_ = m / LB, ss_ = m - bb_ * LB;
#pragma unroll
    for (int t = 0; t < 2; ++t) {
      const f32x4 v0 = acc[i][2 * t], v1 = acc[i][2 * t + 1];
      const int n = nw + t * 32 + quad * 8;
      const uint4 pk = make_uint4(pack2(v0[0], v0[1]), pack2(v0[2], v0[3]), pack2(v1[0], v1[1]), pack2(v1[2], v1[3]));
      switch (g.epi) {
        case EPI_U_EVEN: {
          if (n < 2096) *(uint4*)((bf16_t*)(p.ws + OFF_UE) + (size_t)m * 2304 + n) = pk;
          if (n >= 2080 && n < 2096) {
            float* gp = (float*)(p.ws + OFF_GATES) + (size_t)m * 32 + (n - 2080);
            *(float4*)gp = make_float4(v0[0], v0[1], v0[2], v0[3]); *(float4*)(gp + 4) = make_float4(v1[0], v1[1], v1[2], v1[3]);
          }
        } break;
        case EPI_U_ODD: {
          if (n < 1024) *(uint4*)((bf16_t*)(p.ws + OFF_UO) + (size_t)m * 2048 + n) = pk;
          else if (n < 2048) {
            bf16_t* vt = (bf16_t*)(p.ws + OFF_VTO) + ((size_t)(bb_ * 1024 + (n - 1024))) * LB + ss_;
            vt[0] = (bf16_t)(pk.x & 0xffffu); vt[(size_t)1 * LB] = (bf16_t)(pk.x >> 16); vt[(size_t)2 * LB] = (bf16_t)(pk.y & 0xffffu); vt[(size_t)3 * LB] = (bf16_t)(pk.y >> 16);
            vt[(size_t)4 * LB] = (bf16_t)(pk.z & 0xffffu); vt[(size_t)5 * LB] = (bf16_t)(pk.z >> 16); vt[(size_t)6 * LB] = (bf16_t)(pk.w & 0xffffu); vt[(size_t)7 * LB] = (bf16_t)(pk.w >> 16);
          }
          else if (n < 3072) *(uint4*)((bf16_t*)(p.ws + OFF_UO) + (size_t)m * 2048 + (n - 1024)) = pk;
          else if (n < 3104) {
            float* gp = (float*)(p.ws + OFF_GATES) + (size_t)m * 32 + (n - 3072);
            *(float4*)gp = make_float4(v0[0], v0[1], v0[2], v0[3]); *(float4*)(gp + 4) = make_float4(v1[0], v1[1], v1[2], v1[3]);
          }
        } break;
        case EPI_Q: {
          *(uint4*)((bf16_t*)(p.ws + OFF_Q) + (size_t)m * 768 + n) = pk;
        } break;
        case EPI_KV: {
          const int hh = n >> 7, wi = n & 127;
          if (wi < 64) *(uint4*)((bf16_t*)(p.ws + OFF_KN) + (size_t)m * 512 + hh * 64 + wi) = pk;
          else {
            bf16_t* vt = (bf16_t*)(p.ws + OFF_VTE) + ((size_t)(bb_ * 512 + hh * 64 + (wi - 64))) * LB + ss_;
            vt[0] = (bf16_t)(pk.x & 0xffffu); vt[(size_t)1 * LB] = (bf16_t)(pk.x >> 16); vt[(size_t)2 * LB] = (bf16_t)(pk.y & 0xffffu); vt[(size_t)3 * LB] = (bf16_t)(pk.y >> 16);
            vt[(size_t)4 * LB] = (bf16_t)(pk.z & 0xffffu); vt[(size_t)5 * LB] = (bf16_t)(pk.z >> 16); vt[(size_t)6 * LB] = (bf16_t)(pk.w & 0xffffu); vt[(size_t)7 * LB] = (bf16_t)(pk.w >> 16);
          }
        } break;
        case EPI_RESID: {
          const int mr = ss_ < 2048 ? bb_ : 8;
          const float* gp = mod + (size_t)mr * 6144 + g.gate_off + n;
          const float4 g0 = *(const float4*)gp, g1 = *(const float4*)(gp + 4);
          bf16_t* xp = (bf16_t*)(p.ws + OFF_XB) + (size_t)m * DM + n;
          float xf[8]; unpack8(*(const uint4*)xp, xf);
          xf[0] += g0.x * v0[0]; xf[1] += g0.y * v0[1]; xf[2] += g0.z * v0[2]; xf[3] += g0.w * v0[3];
          xf[4] += g1.x * v1[0]; xf[5] += g1.y * v1[1]; xf[6] += g1.z * v1[2]; xf[7] += g1.w * v1[3];
          *(uint4*)xp = packf8(xf);
        } break;
        case EPI_SQRELU: {
          float q[8];
#pragma unroll
          for (int e = 0; e < 4; ++e) { float a_ = fmaxf(v0[e], 0.f), b_ = fmaxf(v1[e], 0.f); q[e] = a_ * a_; q[4 + e] = b_ * b_; }
          *(uint4*)((bf16_t*)(p.ws + OFF_S) + (size_t)m * 4096 + n) = make_uint4(pack2(q[0], q[1]), pack2(q[2], q[3]), pack2(q[4], q[5]), pack2(q[6], q[7]));
        } break;
      }
    }
  }
}

__device__ void conv_tile(const Params& p, int layer, bool even, int tt, int cgp, char* smem, const float (&wreg)[5][16], const float (&breg)[16]) {
  const int tid = tidx();
  const int tok = tid >> 3, sub = tid & 7;
  const int r0 = tt * 64, r = r0 + tok;
  const int b = r / LB, s = r - b * LB;
  const int lo = s < 2048 ? 0 : 2048, hi = s < 2048 ? 2048 : LB;
  const int li = layer >> 1;
  const int ch0 = cgp * 128 + sub * 16;
  const bf16_t* ub; int ldu;
  if (even) { ub = (const bf16_t*)(p.ws + OFF_UE) + 1056; ldu = 2304; }
  else { ub = (const bf16_t*)(p.ws + OFF_UO); ldu = 2048; }
  (void)li;
  float acc[16];
#pragma unroll
  for (int q = 0; q < 16; ++q) acc[q] = breg[q];
#pragma unroll
  for (int j = 0; j < 5; ++j) {
    int ss = s + j - 2;
    if (ss >= lo && ss < hi) {
      const bf16_t* src = ub + (size_t)(r + j - 2) * ldu + ch0;
      uint4 x0 = *(const uint4*)src, x1 = *(const uint4*)(src + 8);
      float xf[16]; unpack8(x0, xf); unpack8(x1, xf + 8);
#pragma unroll
      for (int q = 0; q < 16; ++q) acc[q] += wreg[j][q] * xf[q];
    }
  }
  const bool kscale = (!even) && cgp >= 4;
#pragma unroll
  for (int e = 0; e < 16; ++e) { float v = siluf(acc[e]); acc[e] = kscale ? v * 0.125f : v; }
  bf16_t* rm = nullptr; int ldr = 0, coff = 0;
  bf16_t* tr = nullptr; int trows = 0, troff = 0;
  if (even) {
    if (cgp < 4) { tr = (bf16_t*)(p.ws + OFF_XT); trows = 512; troff = cgp * 128; }
    else if (cgp < 6) { rm = (bf16_t*)(p.ws + OFF_BM); ldr = 256; coff = (cgp - 4) * 128; tr = (bf16_t*)(p.ws + OFF_BMT); trows = 256; troff = (cgp - 4) * 128; }
    else { rm = (bf16_t*)(p.ws + OFF_CM); ldr = 256; coff = (cgp - 6) * 128; }
  } else {
    if (cgp < 4) { rm = (bf16_t*)(p.ws + OFF_QC); ldr = 512; coff = cgp * 128; }
    else { rm = (bf16_t*)(p.ws + OFF_KC); ldr = 512; coff = (cgp - 4) * 128; tr = (bf16_t*)(p.ws + OFF_KT); trows = 512; troff = (cgp - 4) * 128; }
  }
  if (rm) {
    bf16_t* dst = rm + (size_t)r * ldr + coff + sub * 16;
    *(uint4*)dst = packf8(acc); *(uint4*)(dst + 8) = packf8(acc + 8);
  }
  if (tr) {
    bf16_t* T = (bf16_t*)smem;
#pragma unroll
    for (int e = 0; e < 16; ++e) T[(sub * 16 + e) * 72 + tok] = f2bf(acc[e]);
    __syncthreads();
    const int s0 = r0 - (r0 / LB) * LB, b0 = r0 / LB;
#pragma unroll
    for (int i = 0; i < 2; ++i) {
      int idx = tid + i * NT; int chl = idx >> 3, tc = idx & 7;
      *(uint4*)(tr + ((size_t)(b0 * trows + troff + chl)) * LB + s0 + tc * 8) = *(const uint4*)&T[chl * 72 + tc * 8];
    }
    __syncthreads();
  }
}

__device__ void misc_tile(const Params& p, int layer, int tt) {
  const int tid = tidx();
  const int tok = tid >> 3, sub = tid & 7;
  const int r = tt * 64 + tok;
  const int b = r / LB, s = r - b * LB;
  const int e = layer >> 1;
  bf16_t* u = (bf16_t*)(p.ws + OFF_UE) + (size_t)r * 2304;
#pragma unroll
  for (int part = 0; part < 2; ++part) {
    bf16_t* src = u + part * 256 + sub * 32;
    const float* nw = (part ? p.ev_kv_norm_w : p.ev_q_norm_w) + e * 256 + sub * 32;
    float f[32];
#pragma unroll
    for (int q = 0; q < 4; ++q) unpack8(*(const uint4*)(src + q * 8), f + q * 8);
    float ss = 0.f;
#pragma unroll
    for (int q = 0; q < 32; ++q) ss += f[q] * f[q];
    ss += __shfl_xor(ss, 1); ss += __shfl_xor(ss, 2); ss += __shfl_xor(ss, 4);
    float rstd = rsqrtf(ss * (1.f / 256.f) + EPS);
#pragma unroll
    for (int q = 0; q < 32; ++q) f[q] = f[q] * rstd * nw[q];
#pragma unroll
    for (int q = 0; q < 4; ++q) *(uint4*)(src + q * 8) = packf8(f + q * 8);
  }
  if (sub < 4) {
    const int gsel = sub >> 1; const bool hi = sub & 1;
    float x1[8], x2[8], o[8];
    unpack8(*(const uint4*)(u + 512 + gsel * 16), x1);
    unpack8(*(const uint4*)(u + 512 + gsel * 16 + 8), x2);
    if (s < 2048) {
      float pos = (float)(gsel ? (s & 63) : (s >> 6));
      rope8(hi ? x2 : x1, hi ? x1 : x2, pos, hi, o);
    } else {
#pragma unroll
      for (int i = 0; i < 8; ++i) o[i] = hi ? x2[i] : x1[i];
    }
    *(uint4*)((bf16_t*)(p.ws + OFF_KR) + (size_t)r * 32 + gsel * 16 + (hi ? 8 : 0)) = packf8(o);
  } else {
    const float* gt = (const float*)(p.ws + OFF_GATES) + (size_t)r * 32;
    float* dt = (float*)(p.ws + OFF_DT) + (size_t)r * 16;
    float* da = (float*)(p.ws + OFF_DA) + (size_t)r * 16;
#pragma unroll
    for (int i = 0; i < 4; ++i) {
      int idx = (sub - 4) * 4 + i;
      float d = softplusf(gt[idx] + p.ev_dt_bias[e * 16 + idx]);
      dt[idx] = d;
      da[idx] = -d * __expf(p.ev_a_log[e * 16 + idx]);
    }
  }
}

__device__ void conv_phase(const Params& p, int layer, bool even, char* smem) {
  const int ntt = R / 64;
  const int G = gridDim.x, bi = bidx();
  const bool fast = (G & 7) == 0;
  const int tid = tidx(), tok = tid >> 3, sub = tid & 7, li = layer >> 1;
  const float* cw = even ? p.ev_conv_w + li * 5 * 1024 : p.od_conv_w + li * 5 * 1024;
  const float* cb = even ? p.ev_conv_b + li * 1024 : p.od_conv_b + li * 1024;
  const bf16_t* ub = even ? (const bf16_t*)(p.ws + OFF_UE) + 1056 : (const bf16_t*)(p.ws + OFF_UO);
  const int ldu = even ? 2304 : 2048;
  float wreg[5][16], breg[16];
  int cg_cur = -1;
  const int nit = fast ? ((ntt - (bi >> 3) + (G >> 3) - 1) / (G >> 3)) : ((ntt * 8 - bi + G - 1) / G);
  uint4 xa0, xa1, xa2, xa3, xa4, xb0, xb1, xb2, xb3, xb4;
  unsigned vm = 0;
#define CV_DECODE(it_, cgp_, tt_) do { if (fast) { cgp_ = bi & 7; tt_ = (bi >> 3) + (it_) * (G >> 3); } else { const int t_ = bi + (it_) * G; cgp_ = t_ / ntt; tt_ = t_ - cgp_ * ntt; } } while (0)
#define CV_LOAD1(j) do { const int ss_ = s_ + (j) - 2; const bool v_ = (ss_ >= lo_) && (ss_ < hi_); \
    const bf16_t* src_ = ub + (size_t)(v_ ? r_ + (j) - 2 : r_) * ldu + ch0_; xa##j = *(const uint4*)src_; xb##j = *(const uint4*)(src_ + 8); vm |= (v_ ? 1u : 0u) << (j); } while (0)
#define CV_FETCH(it_) do { int cgp_, tt_; CV_DECODE(it_, cgp_, tt_); const int r_ = tt_ * 64 + tok; const int b_ = r_ / LB, s_ = r_ - b_ * LB; \
    const int lo_ = s_ < 2048 ? 0 : 2048, hi_ = s_ < 2048 ? 2048 : LB; const int ch0_ = cgp_ * 128 + sub * 16; vm = 0; \
    CV_LOAD1(0); CV_LOAD1(1); CV_LOAD1(2); CV_LOAD1(3); CV_LOAD1(4); } while (0)
#define CV_TAP(j) do { if ((vm >> (j)) & 1u) { float xf[16]; unpack8(xa##j, xf); unpack8(xb##j, xf + 8); \
    _Pragma("unroll") for (int q = 0; q < 16; ++q) acc[q] += wreg[j][q] * xf[q]; } } while (0)
  if (nit > 0) CV_FETCH(0);
  for (int it = 0; it < nit; ++it) {
    int cgp, tt;
    CV_DECODE(it, cgp, tt);
    if (cgp != cg_cur) {
      cg_cur = cgp;
      const int ch0 = cgp * 128 + sub * 16;
#pragma unroll
      for (int q = 0; q < 4; ++q) {
        float4 t4 = *(const float4*)(cb + ch0 + q * 4);
        breg[q * 4] = t4.x; breg[q * 4 + 1] = t4.y; breg[q * 4 + 2] = t4.z; breg[q * 4 + 3] = t4.w;
#pragma unroll
        for (int j = 0; j < 5; ++j) {
          float4 w4 = *(const float4*)(cw + j * 1024 + ch0 + q * 4);
          wreg[j][q * 4] = w4.x; wreg[j][q * 4 + 1] = w4.y; wreg[j][q * 4 + 2] = w4.z; wreg[j][q * 4 + 3] = w4.w;
        }
      }
    }
    const int r0 = tt * 64, r = r0 + tok;
    float acc[16];
#pragma unroll
    for (int q = 0; q < 16; ++q) acc[q] = breg[q];
    CV_TAP(0); CV_TAP(1); CV_TAP(2); CV_TAP(3); CV_TAP(4);
    if (it + 1 < nit) CV_FETCH(it + 1);
    const bool kscale = (!even) && cgp >= 4;
#pragma unroll
    for (int e = 0; e < 16; ++e) { float v = siluf(acc[e]); acc[e] = kscale ? v * 0.125f : v; }
    bf16_t* rm = nullptr; int ldr = 0, coff = 0;
    bf16_t* tr = nullptr; int trows = 0, troff = 0;
    if (even) {
      if (cgp < 4) { tr = (bf16_t*)(p.ws + OFF_XT); trows = 512; troff = cgp * 128; }
      else if (cgp < 6) { rm = (bf16_t*)(p.ws + OFF_BM); ldr = 256; coff = (cgp - 4) * 128; tr = (bf16_t*)(p.ws + OFF_BMT); trows = 256; troff = (cgp - 4) * 128; }
      else { rm = (bf16_t*)(p.ws + OFF_CM); ldr = 256; coff = (cgp - 6) * 128; }
    } else {
      if (cgp < 4) { rm = (bf16_t*)(p.ws + OFF_QC); ldr = 512; coff = cgp * 128; }
      else { rm = (bf16_t*)(p.ws + OFF_KC); ldr = 512; coff = (cgp - 4) * 128; tr = (bf16_t*)(p.ws + OFF_KT); trows = 512; troff = (cgp - 4) * 128; }
    }
    if (rm) {
      bf16_t* dst = rm + (size_t)r * ldr + coff + sub * 16;
      *(uint4*)dst = packf8(acc); *(uint4*)(dst + 8) = packf8(acc + 8);
    }
    if (tr) {
      bf16_t* T = (bf16_t*)smem;
#pragma unroll
      for (int e = 0; e < 16; ++e) T[(sub * 16 + e) * 72 + tok] = f2bf(acc[e]);
      __syncthreads();
      const int s0 = r0 - (r0 / LB) * LB, b0 = r0 / LB;
#pragma unroll
      for (int i = 0; i < 2; ++i) {
        int idx = tid + i * NT; int chl = idx >> 3, tc = idx & 7;
        *(uint4*)(tr + ((size_t)(b0 * trows + troff + chl)) * LB + s0 + tc * 8) = *(const uint4*)&T[chl * 72 + tc * 8];
      }
      __syncthreads();
    }
  }
#undef CV_DECODE
#undef CV_LOAD1
#undef CV_FETCH
#undef CV_TAP
  if (even) for (int t = bi; t < ntt; t += G) misc_tile(p, layer, t);
}

__device__ void attn_tile(const Params& p, int b, int hh, int qt, char* smem) {
  bf16_t* Ks = (bf16_t*)smem;
  bf16_t* Vs = Ks + 2 * 64 * 104;
  const int tid = tidx(), lane = tid & 63, wave = __builtin_amdgcn_readfirstlane(tid >> 6), l15 = lane & 15, quad = lane >> 4;
  const bf16_t* Qg = (const bf16_t*)(p.ws + OFF_Q);
  const bf16_t* KNg = (const bf16_t*)(p.ws + OFF_KN);
  const bf16_t* KRg = (const bf16_t*)(p.ws + OFF_KR);
  const bf16_t* VTg = (const bf16_t*)(p.ws + OFF_VTE);
  const bool is_ctx = (qt == 8);
  const int kbeg = is_ctx ? 2048 : 0;
  const int nkt = (LB - kbeg) / 64;
  bf16x8 qf[2][3];
#pragma unroll
  for (int qi = 0; qi < 2; ++qi) {
    const int sq = qt * 256 + wave * 32 + qi * 16 + l15;
    const bf16_t* qp = Qg + (size_t)(b * LB + sq) * 768 + hh * 96;
#pragma unroll
    for (int ks = 0; ks < 3; ++ks) qf[qi][ks] = *(const bf16x8*)(qp + ks * 32 + quad * 8);
    if (!is_ctx) {
      float own[8], par[8], o[8];
      unpack8(*(const uint4*)(qp + 64 + quad * 8), own);
      unpack8(*(const uint4*)(qp + 64 + (quad ^ 1) * 8), par);
      float pos = (float)((quad < 2) ? (sq >> 6) : (sq & 63));
      rope8(own, par, pos, (quad & 1) != 0, o);
      union { uint4 u; bf16x8 v; } cv; cv.u = packf8(o);
      qf[qi][2] = cv.v;
    }
  }
  f32x4 o[4][2];
#pragma unroll
  for (int i = 0; i < 4; ++i)
#pragma unroll
    for (int j = 0; j < 2; ++j) o[i][j] = (f32x4){0.f, 0.f, 0.f, 0.f};
  float mrun[2] = {-1e30f, -1e30f}, lrun[2] = {0.f, 0.f};
  uint4 rk0, rk1, rv;
  const int kr0 = tid >> 3, kc0 = (tid & 7) * 8;
  const int kr1 = tid >> 2, kc1 = (tid & 3) * 8;
#define ALOAD(kt) do { \
    const size_t rowb_ = (size_t)b * LB + kbeg + (kt) * 64; \
    rk0 = *(const uint4*)(KNg + (rowb_ + kr0) * 512 + hh * 64 + kc0); \
    if (tid < 256) rk1 = *(const uint4*)(KRg + (rowb_ + kr1) * 32 + kc1); \
    rv = *(const uint4*)(VTg + ((size_t)(b * 512 + hh * 64 + kr0)) * LB + kbeg + (kt) * 64 + kc0); } while (0)
#define ASTORE(buf) do { \
    *(uint4*)(Ks + ((buf) * 64 + kr0) * 104 + kc0) = rk0; \
    if (tid < 256) *(uint4*)(Ks + ((buf) * 64 + kr1) * 104 + 64 + kc1) = rk1; \
    *(uint4*)(Vs + ((buf) * 64 + kr0) * 72 + kc0) = rv; } while (0)
  __syncthreads();
  ALOAD(0); ASTORE(0);
  __syncthreads();
  const float SCALE = 0.10206207261596577f * 1.4426950408889634f;
#pragma unroll 1
  for (int kt = 0; kt < nkt; ++kt) {
    const int buf = kt & 1;
    if (kt + 1 < nkt) ALOAD(kt + 1);
    f32x4 sacc[4][2];
#pragma unroll
    for (int i = 0; i < 4; ++i)
#pragma unroll
      for (int j = 0; j < 2; ++j) sacc[i][j] = (f32x4){0.f, 0.f, 0.f, 0.f};
#pragma unroll
    for (int ks = 0; ks < 3; ++ks) {
#pragma unroll
      for (int kti = 0; kti < 4; ++kti) {
        bf16x8 kf = *(const bf16x8*)(Ks + (buf * 64 + kti * 16 + l15) * 104 + ks * 32 + quad * 8);
#pragma unroll
        for (int qi = 0; qi < 2; ++qi) sacc[kti][qi] = mfma16(kf, qf[qi][ks], sacc[kti][qi]);
      }
    }
#pragma unroll
    for (int qi = 0; qi < 2; ++qi) {
      float mx = -1e30f;
#pragma unroll
      for (int kti = 0; kti < 4; ++kti)
#pragma unroll
        for (int e = 0; e < 4; ++e) mx = fmaxf(mx, sacc[kti][qi][e]);
      mx = fmaxf(mx, __shfl_xor(mx, 16)); mx = fmaxf(mx, __shfl_xor(mx, 32));
      float mnew = fmaxf(mrun[qi], mx * SCALE);
      float alpha = __builtin_amdgcn_exp2f(mrun[qi] - mnew);
      mrun[qi] = mnew;
      float ls = 0.f;
#pragma unroll
      for (int kti = 0; kti < 4; ++kti)
#pragma unroll
        for (int e = 0; e < 4; ++e) { float pv = __builtin_amdgcn_exp2f(fmaf(sacc[kti][qi][e], SCALE, -mnew)); sacc[kti][qi][e] = pv; ls += pv; }
      lrun[qi] = lrun[qi] * alpha + ls;
#pragma unroll
      for (int dvt = 0; dvt < 4; ++dvt) o[dvt][qi] *= alpha;
    }
#pragma unroll
    for (int kp = 0; kp < 2; ++kp) {
      bf16x8 pf[2];
#pragma unroll
      for (int qi = 0; qi < 2; ++qi) pf[qi] = pack8(sacc[2 * kp][qi], sacc[2 * kp + 1][qi]);
#pragma unroll
      for (int dvt = 0; dvt < 4; ++dvt) {
        const bf16_t* vp = Vs + (buf * 64 + dvt * 16 + l15) * 72 + quad * 4;
        bf16x8 vf = cat44(*(const uint2*)(vp + (2 * kp) * 16), *(const uint2*)(vp + (2 * kp + 1) * 16));
#pragma unroll
        for (int qi = 0; qi < 2; ++qi) o[dvt][qi] = mfma16(vf, pf[qi], o[dvt][qi]);
      }
    }
    if (kt + 1 < nkt) ASTORE(buf ^ 1);
    __syncthreads();
  }
#undef ALOAD
#undef ASTORE
  bf16_t* cat = (bf16_t*)((char*)p.out);
#pragma unroll
  for (int qi = 0; qi < 2; ++qi) {
    float l = lrun[qi];
    l += __shfl_xor(l, 16); l += __shfl_xor(l, 32);
    float inv = __builtin_amdgcn_rcpf(l);
    const int sq = qt * 256 + wave * 32 + qi * 16 + l15;
#pragma unroll
    for (int dvt = 0; dvt < 4; ++dvt) {
      f32x4 v = o[dvt][qi] * inv;
      *(uint2*)(cat + (size_t)(b * LB + sq) * DM + hh * 64 + dvt * 16 + quad * 4) = pack4(v);
    }
  }
}

__device__ void ssd_tile(const Params& p, int e, int b, int d, int hh, char* smem) {
  bf16_t* Cm = (bf16_t*)smem;
  bf16_t* Bm = Cm + 128 * 136;
  bf16_t* BmT = Bm + 128 * 136;
  bf16_t* XT = BmT + 128 * 136;
  bf16_t* Hs = XT + 64 * 136;
  float* acum = (float*)(Hs + 64 * 136);
  float* toend = acum + 128;
  float* dts = toend + 128;
  float* scal = dts + 128;
  const int tid = tidx(), lane = tid & 63, wave = __builtin_amdgcn_readfirstlane(tid >> 6), l15 = lane & 15, quad = lane >> 4;
  const int g = hh >> 2;
  const float Dk = p.ev_d_skip[e * 8 + hh];
  const bf16_t* CMg = (const bf16_t*)(p.ws + OFF_CM);
  const bf16_t* BMg = (const bf16_t*)(p.ws + OFF_BM);
  const bf16_t* BMTg = (const bf16_t*)(p.ws + OFF_BMT);
  const bf16_t* XTg = (const bf16_t*)(p.ws + OFF_XT);
  const float* DTg = (const float*)(p.ws + OFF_DT);
  const float* DAg = (const float*)(p.ws + OFF_DA);
  bf16_t* Yg = (bf16_t*)(p.ws + OFF_Y) + (size_t)d * R * 512;
  f32x4 hst[4];
#pragma unroll
  for (int i = 0; i < 4; ++i) hst[i] = (f32x4){0.f, 0.f, 0.f, 0.f};
  __syncthreads();
  for (int idx = tid; idx < 64 * 136 / 8; idx += NT) *(uint4*)(Hs + idx * 8) = make_uint4(0, 0, 0, 0);
  const int tcol = wave * 16 + l15;
#pragma unroll 1
  for (int step = 0; step < 18; ++step) {
    const int chunk = d ? (17 - step) : (step < 2 ? 16 + step : step - 2);
    const int row0 = b * LB + chunk * 128, pos0 = chunk * 128;
    __syncthreads();
    if (wave == 0) {
      const int i0 = d ? 127 - 2 * lane : 2 * lane, i1 = d ? 126 - 2 * lane : 2 * lane + 1;
      float a0 = DAg[(size_t)(row0 + i0) * 16 + d * 8 + hh], a1 = DAg[(size_t)(row0 + i1) * 16 + d * 8 + hh];
      float t0 = DTg[(size_t)(row0 + i0) * 16 + d * 8 + hh], t1 = DTg[(size_t)(row0 + i1) * 16 + d * 8 + hh];
      float loc = a0 + a1;
      float incl = scan_add(loc, lane);
      float excl = incl - loc;
      float c0 = excl + a0, c1 = excl + loc;
      float total = __shfl(incl, 63);
      acum[i0] = c0; acum[i1] = c1;
      toend[i0] = __expf(total - c0) * t0; toend[i1] = __expf(total - c1) * t1;
      dts[i0] = t0; dts[i1] = t1;
      if (lane == 0) scal[0] = total;
    }
    uint4 rbt[4];
#pragma unroll
    for (int i = 0; i < 4; ++i) {
      int idx = tid + i * NT; int rr = idx >> 4, cc = (idx & 15) * 8;
      *(uint4*)(Cm + rr * 136 + cc) = *(const uint4*)(CMg + (size_t)(row0 + rr) * 256 + g * 128 + cc);
      *(uint4*)(Bm + rr * 136 + cc) = *(const uint4*)(BMg + (size_t)(row0 + rr) * 256 + g * 128 + cc);
      rbt[i] = *(const uint4*)(BMTg + ((size_t)(b * 256 + g * 128 + rr)) * LB + pos0 + cc);
    }
#pragma unroll
    for (int i = 0; i < 2; ++i) {
      int idx = tid + i * NT; int rr = idx >> 4, cc = (idx & 15) * 8;
      *(uint4*)(XT + rr * 136 + cc) = *(const uint4*)(XTg + ((size_t)(b * 512 + hh * 64 + rr)) * LB + pos0 + cc);
    }
    __syncthreads();
#pragma unroll
    for (int i = 0; i < 4; ++i) {
      int idx = tid + i * NT; int rr = idx >> 4, cc = (idx & 15) * 8;
      float f[8]; unpack8(rbt[i], f);
#pragma unroll
      for (int q = 0; q < 8; ++q) f[q] *= toend[cc + q];
      *(uint4*)(BmT + rr * 136 + cc) = packf8(f);
    }
    const float total = scal[0];
    const float act = acum[tcol];
    bf16x8 cfr[4];
#pragma unroll
    for (int ks = 0; ks < 4; ++ks) cfr[ks] = *(const bf16x8*)(Cm + tcol * 136 + ks * 32 + quad * 8);
    f32x4 y[4];
#pragma unroll
    for (int i = 0; i < 4; ++i) y[i] = (f32x4){0.f, 0.f, 0.f, 0.f};
#pragma unroll
    for (int ks = 0; ks < 4; ++ks)
#pragma unroll
      for (int pt = 0; pt < 4; ++pt) {
        bf16x8 af = *(const bf16x8*)(Hs + (pt * 16 + l15) * 136 + ks * 32 + quad * 8);
        y[pt] = mfma16(af, cfr[ks], y[pt]);
      }
    {
      float et = __expf(act);
#pragma unroll
      for (int pt = 0; pt < 4; ++pt) y[pt] *= et;
    }
    f32x4 w[8];
#pragma unroll
    for (int i = 0; i < 8; ++i) w[i] = (f32x4){0.f, 0.f, 0.f, 0.f};
#pragma unroll
    for (int ks = 0; ks < 4; ++ks)
#pragma unroll
      for (int st = 0; st < 8; ++st) {
        bf16x8 af = *(const bf16x8*)(Bm + (st * 16 + l15) * 136 + ks * 32 + quad * 8);
        w[st] = mfma16(af, cfr[ks], w[st]);
      }
#pragma unroll
    for (int st = 0; st < 8; ++st)
#pragma unroll
      for (int jj = 0; jj < 4; ++jj) {
        int s = st * 16 + quad * 4 + jj;
        bool valid = d ? (s >= tcol) : (s <= tcol);
        float dec = valid ? __expf(act - acum[s]) * dts[s] : 0.f;
        w[st][jj] = valid ? w[st][jj] * dec : 0.f;
      }
#pragma unroll
    for (int kp = 0; kp < 4; ++kp) {
      bf16x8 pf = pack8(w[2 * kp], w[2 * kp + 1]);
#pragma unroll
      for (int pt = 0; pt < 4; ++pt) {
        const bf16_t* vp = XT + (pt * 16 + l15) * 136 + quad * 4;
        bf16x8 vf = cat44(*(const uint2*)(vp + (2 * kp) * 16), *(const uint2*)(vp + (2 * kp + 1) * 16));
        y[pt] = mfma16(vf, pf, y[pt]);
      }
    }
    if (d == 0) {
#pragma unroll
      for (int pt = 0; pt < 4; ++pt)
#pragma unroll
        for (int jj = 0; jj < 4; ++jj) y[pt][jj] += Dk * bf2f(XT[(pt * 16 + quad * 4 + jj) * 136 + tcol]);
    }
#pragma unroll
    for (int pt = 0; pt < 4; ++pt)
      *(uint2*)(Yg + (size_t)(row0 + tcol) * 512 + hh * 64 + pt * 16 + quad * 4) = pack4(y[pt]);
    __syncthreads();
    {
      float edec = __expf(total);
#pragma unroll
      for (int pt = 0; pt < 4; ++pt) hst[pt] *= edec;
#pragma unroll
      for (int ks = 0; ks < 4; ++ks) {
        bf16x8 af = *(const bf16x8*)(BmT + (wave * 16 + l15) * 136 + ks * 32 + quad * 8);
#pragma unroll
        for (int pt = 0; pt < 4; ++pt) {
          bf16x8 bfv = *(const bf16x8*)(XT + (pt * 16 + l15) * 136 + ks * 32 + quad * 8);
          hst[pt] = mfma16(af, bfv, hst[pt]);
        }
      }
#pragma unroll
      for (int pt = 0; pt < 4; ++pt) *(uint2*)(Hs + (pt * 16 + l15) * 136 + wave * 16 + quad * 4) = pack4(hst[pt]);
    }
  }
  __syncthreads();
}

__device__ void mlstm_tile(const Params& p, int o_, int b, int d, int hh, int vh, char* smem) {
  bf16_t* Qs = (bf16_t*)smem;
  bf16_t* Ks = Qs + 128 * 72;
  bf16_t* KTs = Ks + 128 * 72;
  bf16_t* VT = KTs + 64 * 136;
  bf16_t* Cs = VT + 80 * 136;
  float* bb = (float*)(Cs + 80 * 72);
  float* icb = bb + 128;
  float* mts = icb + 128;
  float* wts = mts + 128;
  float* scal = wts + 128;
  const int tid = tidx(), lane = tid & 63, wave = __builtin_amdgcn_readfirstlane(tid >> 6), l15 = lane & 15, quad = lane >> 4;
  const float ib = p.od_i_bias[o_ * 16 + d * 8 + hh], fb = p.od_f_bias[o_ * 16 + d * 8 + hh];
  const bf16_t* QCg = (const bf16_t*)(p.ws + OFF_QC);
  const bf16_t* KCg = (const bf16_t*)(p.ws + OFF_KC);
  const bf16_t* KTg = (const bf16_t*)(p.ws + OFF_KT);
  const bf16_t* VTg = (const bf16_t*)(p.ws + OFF_VTO);
  const float* Gg = (const float*)(p.ws + OFF_GATES);
  bf16_t* Hg = (bf16_t*)(p.ws + OFF_HB) + (size_t)d * R * 1024;
  __syncthreads();
  for (int idx = tid; idx < 80 * 72 / 8; idx += NT) *(uint4*)(Cs + idx * 8) = make_uint4(0, 0, 0, 0);
  for (int idx = tid; idx < 16 * 136 / 8; idx += NT) {
    unsigned v = (idx < 136 / 8) ? 0x3F803F80u : 0u;
    *(uint4*)(VT + 64 * 136 + idx * 8) = make_uint4(v, v, v, v);
  }
  const int dkt = wave & 3, vbase = (wave >> 2) * 2;
  f32x4 cst[3];
#pragma unroll
  for (int i = 0; i < 3; ++i) cst[i] = (f32x4){0.f, 0.f, 0.f, 0.f};
  float m_in = 0.f;
  const int tcol = wave * 16 + l15;
  uint4 pq0, pq1, pk0, pk1, pv0, pv1, rkt0, rkt1;
  float pf0 = 0.f, pf1 = 0.f, pg0 = 0.f, pg1 = 0.f;
#define ML_FETCH1(i_, row0n_, pos0n_) do { const int idx_ = tid + (i_) * NT; const int rr_ = idx_ >> 3, cc_ = (idx_ & 7) * 8, r2_ = idx_ >> 4, c2_ = (idx_ & 15) * 8; \
      pq##i_ = *(const uint4*)(QCg + (size_t)((row0n_) + rr_) * 512 + hh * 64 + cc_); \
      pk##i_ = *(const uint4*)(KCg + (size_t)((row0n_) + rr_) * 512 + hh * 64 + cc_); \
      rkt##i_ = *(const uint4*)(KTg + ((size_t)(b * 512 + hh * 64 + r2_)) * LB + (pos0n_) + c2_); \
      pv##i_ = *(const uint4*)(VTg + ((size_t)(b * 1024 + hh * 128 + vh * 64 + r2_)) * LB + (pos0n_) + c2_); } while (0)
#define ML_FETCH(chunk_) do { const int row0n_ = b * LB + (chunk_) * 128, pos0n_ = (chunk_) * 128; \
    ML_FETCH1(0, row0n_, pos0n_); ML_FETCH1(1, row0n_, pos0n_); \
    if (wave == 0) { const int i0_ = d ? 127 - 2 * lane : 2 * lane, i1_ = d ? 126 - 2 * lane : 2 * lane + 1; \
      pf0 = Gg[(size_t)(row0n_ + i0_) * 32 + 16 + d * 8 + hh]; pf1 = Gg[(size_t)(row0n_ + i1_) * 32 + 16 + d * 8 + hh]; \
      pg0 = Gg[(size_t)(row0n_ + i0_) * 32 + d * 8 + hh]; pg1 = Gg[(size_t)(row0n_ + i1_) * 32 + d * 8 + hh]; } } while (0)
  ML_FETCH(d ? 17 : 16);
#pragma unroll 1
  for (int step = 0; step < 18; ++step) {
    const int chunk = d ? (17 - step) : (step < 2 ? 16 + step : step - 2);
    const int row0 = b * LB + chunk * 128, pos0 = chunk * 128;
    __syncthreads();
    if (wave == 0) {
      const int i0 = d ? 127 - 2 * lane : 2 * lane, i1 = d ? 126 - 2 * lane : 2 * lane + 1;
      const float f0 = pf0 + fb, f1 = pf1 + fb, g0 = pg0 + ib, g1 = pg1 + ib;
      float lf0 = -softplusf(-f0), lf1 = -softplusf(-f1);
      float loc = lf0 + lf1;
      float incl = scan_add(loc, lane);
      float excl = incl - loc;
      float b0 = excl + lf0, b1 = excl + loc;
      float blast = __shfl(incl, 63);
      float c0 = g0 - b0, c1 = g1 - b1;
      float lm = fmaxf(c0, c1);
      float pmi = scan_max(lm, lane);
      float pme = __shfl_up(pmi, 1); if (lane == 0) pme = -1e30f;
      float pm0 = fmaxf(pme, c0), pm1 = pmi;
      float mt0 = b0 + fmaxf(m_in, pm0), mt1 = b1 + fmaxf(m_in, pm1);
      float mw = blast + __shfl(pmi, 63);
      float m_new = fmaxf(blast + m_in, mw);
      float keepS = __expf(blast + m_in - m_new);
      bb[i0] = b0; bb[i1] = b1; icb[i0] = c0; icb[i1] = c1; mts[i0] = mt0; mts[i1] = mt1;
      wts[i0] = __expf(blast + c0 - m_new); wts[i1] = __expf(blast + c1 - m_new);
      if (lane == 0) { scal[0] = m_new; scal[1] = keepS; }
    }
    uint4 ckt0, ckt1;
    {
      int idx = tid; int rr = idx >> 3, cc = (idx & 7) * 8, r2 = idx >> 4, c2 = (idx & 15) * 8;
      *(uint4*)(Qs + rr * 72 + cc) = pq0; *(uint4*)(Ks + rr * 72 + cc) = pk0; *(uint4*)(VT + r2 * 136 + c2) = pv0; ckt0 = rkt0;
      idx = tid + NT; rr = idx >> 3; cc = (idx & 7) * 8; r2 = idx >> 4; c2 = (idx & 15) * 8;
      *(uint4*)(Qs + rr * 72 + cc) = pq1; *(uint4*)(Ks + rr * 72 + cc) = pk1; *(uint4*)(VT + r2 * 136 + c2) = pv1; ckt1 = rkt1;
    }
    if (step + 1 < 18) { const int nchunk = d ? (16 - step) : (step + 1 < 2 ? 17 : step - 1); ML_FETCH(nchunk); }
    __syncthreads();
    {
      int idx = tid; int r2 = idx >> 4, c2 = (idx & 15) * 8;
      float f[8]; unpack8(ckt0, f);
#pragma unroll
      for (int q = 0; q < 8; ++q) f[q] *= wts[c2 + q];
      *(uint4*)(KTs + r2 * 136 + c2) = packf8(f);
      idx = tid + NT; r2 = idx >> 4; c2 = (idx & 15) * 8;
      unpack8(ckt1, f);
#pragma unroll
      for (int q = 0; q < 8; ++q) f[q] *= wts[c2 + q];
      *(uint4*)(KTs + r2 * 136 + c2) = packf8(f);
    }
    const float m_new = scal[0], keepS = scal[1];
    const float bt = bb[tcol], mtt = mts[tcol];
    bf16x8 qfr[2];
#pragma unroll
    for (int ks = 0; ks < 2; ++ks) qfr[ks] = *(const bf16x8*)(Qs + tcol * 72 + ks * 32 + quad * 8);
    f32x4 a[8];
#pragma unroll
    for (int i = 0; i < 8; ++i) a[i] = (f32x4){0.f, 0.f, 0.f, 0.f};
#pragma unroll
    for (int ks = 0; ks < 2; ++ks)
#pragma unroll
      for (int st = 0; st < 8; ++st) {
        bf16x8 af = *(const bf16x8*)(Ks + (st * 16 + l15) * 72 + ks * 32 + quad * 8);
        a[st] = mfma16(af, qfr[ks], a[st]);
      }
#pragma unroll
    for (int st = 0; st < 8; ++st)
#pragma unroll
      for (int jj = 0; jj < 4; ++jj) {
        int s = st * 16 + quad * 4 + jj;
        bool valid = d ? (s >= tcol) : (s <= tcol);
        float dm = valid ? __expf(bt + icb[s] - mtt) : 0.f;
        a[st][jj] = valid ? a[st][jj] * dm : 0.f;
      }
    bf16x8 pfa[4];
#pragma unroll
    for (int kp = 0; kp < 4; ++kp) pfa[kp] = pack8(a[2 * kp], a[2 * kp + 1]);
    f32x4 nu[5];
#pragma unroll
    for (int i = 0; i < 5; ++i) nu[i] = (f32x4){0.f, 0.f, 0.f, 0.f};
#pragma unroll
    for (int ks = 0; ks < 2; ++ks)
#pragma unroll
      for (int vt = 0; vt < 5; ++vt) {
        bf16x8 af = *(const bf16x8*)(Cs + (vt * 16 + l15) * 72 + ks * 32 + quad * 8);
        nu[vt] = mfma16(af, qfr[ks], nu[vt]);
      }
    {
      float kt_ = __expf(bt + m_in - mtt);
#pragma unroll
      for (int vt = 0; vt < 5; ++vt) nu[vt] *= (DBG_NOSTATE ? 0.f : kt_);
    }
#pragma unroll
    for (int kp = 0; kp < 4; ++kp) {
      bf16x8 pf = pfa[kp];
#pragma unroll
      for (int vt = 0; vt < 5; ++vt) {
        const bf16_t* vp = VT + (vt * 16 + l15) * 136 + quad * 4;
        bf16x8 vf = cat44(*(const uint2*)(vp + (2 * kp) * 16), *(const uint2*)(vp + (2 * kp + 1) * 16));
        nu[vt] = mfma16(vf, pf, nu[vt]);
      }
    }
    {
      float den = __shfl(nu[4][0], l15);
      float dd = fmaxf(fabsf(den), __expf(-mtt));
      float inv = __builtin_amdgcn_rcpf(dd);
#pragma unroll
      for (int vt = 0; vt < 4; ++vt) {
        f32x4 v = nu[vt] * inv;
        *(uint2*)(Hg + (size_t)(row0 + tcol) * 1024 + hh * 128 + vh * 64 + vt * 16 + quad * 4) = pack4(v);
      }
    }
    __syncthreads();
#pragma unroll
    for (int k = 0; k < 3; ++k) cst[k] *= keepS;
#pragma unroll
    for (int ks = 0; ks < 4; ++ks) {
      bf16x8 af = *(const bf16x8*)(KTs + (dkt * 16 + l15) * 136 + ks * 32 + quad * 8);
#pragma unroll
      for (int k = 0; k < 3; ++k) {
        {
          const int vt_ = (k < 2) ? (vbase + k) : 4;
          bf16x8 bfv = *(const bf16x8*)(VT + (vt_ * 16 + l15) * 136 + ks * 32 + quad * 8);
          cst[k] = mfma16(af, bfv, cst[k]);
        }
      }
    }
#pragma unroll
    for (int k = 0; k < 3; ++k)
      { const int vt_ = (k < 2) ? (vbase + k) : 4; *(uint2*)(Cs + (vt_ * 16 + l15) * 72 + dkt * 16 + quad * 4) = pack4(cst[k]); }
    m_in = m_new;
  }
#undef ML_FETCH
#undef ML_FETCH1
  __syncthreads();
}

__device__ void gnorm_phase(const Params& p, int layer) {
  const int lane = tidx() & 63, wave = __builtin_amdgcn_readfirstlane(tidx() >> 6);
  const int e = layer >> 1;
  const bf16_t* Y0 = (const bf16_t*)(p.ws + OFF_Y);
  const bf16_t* Y1 = Y0 + (size_t)R * 512;
  const bf16_t* U = (const bf16_t*)(p.ws + OFF_UE);
  bf16_t* cat = (bf16_t*)((char*)p.out);
  const int nwv = gridDim.x * 8;
  const int c0 = lane * 8;
  float nwt[8];
#pragma unroll
  for (int i = 0; i < 8; ++i) nwt[i] = p.ev_ssm_norm_w[e * 512 + c0 + i];
  for (int r0 = bidx() * 8 + wave; r0 < R; r0 += nwv * 3) {
    uint4 a0[3], a1[3], az[3];
#pragma unroll
    for (int u = 0; u < 3; ++u) {
      const int r = r0 + u * nwv;
      if (r < R) {
        a0[u] = *(const uint4*)(Y0 + (size_t)r * 512 + c0);
        a1[u] = *(const uint4*)(Y1 + (size_t)r * 512 + c0);
        az[u] = *(const uint4*)(U + (size_t)r * 2304 + 544 + c0);
      }
    }
#pragma unroll
    for (int u = 0; u < 3; ++u) {
      const int r = r0 + u * nwv;
      if (r >= R) continue;
      float y0[8], y1[8], z[8];
      unpack8(a0[u], y0); unpack8(a1[u], y1); unpack8(az[u], z);
      float gv[8]; float ss = 0.f;
#pragma unroll
      for (int i = 0; i < 8; ++i) { gv[i] = (y0[i] + y1[i]) * siluf(z[i]); ss += gv[i] * gv[i]; }
#pragma unroll
      for (int o = 16; o > 0; o >>= 1) ss += __shfl_xor(ss, o);
      const float rstd = rsqrtf(ss * (1.f / 256.f) + EPS);
#pragma unroll
      for (int i = 0; i < 8; ++i) gv[i] = gv[i] * rstd * nwt[i];
      *(uint4*)(cat + (size_t)r * DM + 512 + c0) = packf8(gv);
    }
  }
}

__device__ void finish_phase(const Params& p, int layer) {
  const int lane = tidx() & 63, wave = __builtin_amdgcn_readfirstlane(tidx() >> 6);
  const int o_ = layer >> 1;
  const bf16_t* H0 = (const bf16_t*)(p.ws + OFF_HB);
  const bf16_t* H1 = H0 + (size_t)R * 1024;
  const bf16_t* U = (const bf16_t*)(p.ws + OFF_UO);
  bf16_t* cat = (bf16_t*)((char*)p.out);
  const int nwv = gridDim.x * 8;
  const int c0 = lane * 16;
  const float* nw = p.od_head_norm_w + o_ * 1024 + c0;
  for (int r0 = bidx() * 8 + wave; r0 < R; r0 += nwv * 3) {
    uint4 q0[3][2], q1[3][2], qg[3][2];
#pragma unroll
    for (int u = 0; u < 3; ++u) {
      const int r = r0 + u * nwv;
      if (r < R) {
#pragma unroll
        for (int k = 0; k < 2; ++k) {
          q0[u][k] = *(const uint4*)(H0 + (size_t)r * 1024 + c0 + k * 8);
          q1[u][k] = *(const uint4*)(H1 + (size_t)r * 1024 + c0 + k * 8);
          qg[u][k] = *(const uint4*)(U + (size_t)r * 2048 + 1024 + c0 + k * 8);
        }
      }
    }
#pragma unroll
    for (int u = 0; u < 3; ++u) {
      const int r = r0 + u * nwv;
      if (r >= R) continue;
      float h[16], t[16], og[16];
      unpack8(q0[u][0], h); unpack8(q0[u][1], h + 8);
      unpack8(q1[u][0], t); unpack8(q1[u][1], t + 8);
      unpack8(qg[u][0], og); unpack8(qg[u][1], og + 8);
      float ss = 0.f;
#pragma unroll
      for (int i = 0; i < 16; ++i) { h[i] += t[i]; ss += h[i] * h[i]; }
      ss += __shfl_xor(ss, 1); ss += __shfl_xor(ss, 2); ss += __shfl_xor(ss, 4);
      const float rstd = rsqrtf(ss * (1.f / 128.f) + EPS);
#pragma unroll
      for (int i = 0; i < 16; ++i) h[i] = sigmoidf(og[i]) * h[i] * rstd * nw[i];
      *(uint4*)(cat + (size_t)r * DM + c0) = packf8(h);
      *(uint4*)(cat + (size_t)r * DM + c0 + 8) = packf8(h + 8);
    }
  }
}

#define XB_TMO      128
#define XB_XCNT(j)  (256  + 64 * (j))
#define XB_XSUB(j)  (1280 + 64 * (j))
#define XB_XGEN(j)  (2304 + 64 * (j))
#define XB_TOP      3328
#define XB_TOPGEN   3392
#define XCD_BAR_WORDS 3456
#define XB_SPIN_CAP (1u << 20)
#define LAS __attribute__((address_space(3)))
__device__ __forceinline__ unsigned xb_ld(unsigned* p)              { return __hip_atomic_load(p, __ATOMIC_RELAXED, __HIP_MEMORY_SCOPE_AGENT); }
__device__ __forceinline__ unsigned xb_add(unsigned* p, unsigned v) { return __hip_atomic_fetch_add(p, v, __ATOMIC_RELAXED, __HIP_MEMORY_SCOPE_AGENT); }
__device__ __forceinline__ unsigned xb_xcc_id() { return (unsigned)__builtin_amdgcn_s_getreg((3 << 11) | 20) & 0xFu; }
#define XB_SPIN(cond, bar) do { unsigned _sp = 0; while (cond) { __builtin_amdgcn_s_sleep(1); \
    if ((++_sp & 255u) == 0u) { if (xb_ld(&(bar)[XB_TMO])) break; if (_sp > XB_SPIN_CAP) { atomicAdd(&(bar)[XB_TMO], 1u); break; } } } } while (0)
struct XcdBarrier { unsigned* bar; unsigned x; volatile LAS unsigned* st; };
__device__ __forceinline__ XcdBarrier xcd_barrier_post(unsigned* bar, volatile LAS unsigned* st) {
  XcdBarrier b; b.bar = bar; b.x = xb_xcc_id(); b.st = st;
  if (threadIdx.x == 0) (void)xb_add(&bar[XB_XCNT(b.x)], 1u);
  return b;
}
__device__ __forceinline__ void xcd_barrier_complete(unsigned* bar, unsigned x, unsigned& nloc, unsigned& nx) {
  const unsigned G = gridDim.x * gridDim.y * gridDim.z;
  unsigned sum, cnt, mine, sp = 0u;
  for (;;) {
    sum = 0u; cnt = 0u; mine = 0u;
#pragma unroll
    for (unsigned j = 0; j < 16; ++j) { const unsigned c = xb_ld(&bar[XB_XCNT(j)]); sum += c; cnt += (c > 0u) ? 1u : 0u; mine = (j == x) ? c : mine; }
    if (sum == G) break;
    __builtin_amdgcn_s_sleep(1);
    if ((++sp & 255u) == 0u) { if (xb_ld(&bar[XB_TMO])) break; if (sp > XB_SPIN_CAP) { atomicAdd(&bar[XB_TMO], 1u); break; } }
  }
  nloc = mine > 0u ? mine : 1u; nx = cnt > 0u ? cnt : 1u;
}
__device__ __forceinline__ void xcd_barrier(const XcdBarrier& b) {
  asm volatile("s_waitcnt vmcnt(0)" ::: "memory");
  __syncthreads();
  if (threadIdx.x == 0) {
    unsigned* bar = b.bar;
    __builtin_amdgcn_s_waitcnt(0);
    unsigned nloc = b.st[0], nx = b.st[1];
    if (nloc == 0u) { xcd_barrier_complete(bar, b.x, nloc, nx); b.st[0] = nloc; b.st[1] = nx; }
    const unsigned old = xb_add(&bar[XB_XSUB(b.x)], 1u);
    const unsigned gen = old / nloc;
    if (old + 1u == (gen + 1u) * nloc) {
      __builtin_amdgcn_fence(__ATOMIC_RELEASE, "agent");
      asm volatile("s_waitcnt vmcnt(0)" ::: "memory");
      const unsigned og = xb_add(&bar[XB_TOP], 1u);
      const unsigned tg = og / nx;
      if (og + 1u == (tg + 1u) * nx) xb_add(&bar[XB_TOPGEN], 1u);
      else XB_SPIN(xb_ld(&bar[XB_TOPGEN]) == tg, bar);
      __builtin_amdgcn_fence(__ATOMIC_ACQUIRE, "agent");
      xb_add(&bar[XB_XGEN(b.x)], 1u);
      asm volatile("s_waitcnt vmcnt(0)" ::: "memory");
    } else {
      XB_SPIN(xb_ld(&bar[XB_XGEN(b.x)]) == gen, bar);
      __builtin_amdgcn_fence(__ATOMIC_ACQUIRE, "agent");
      asm volatile("s_waitcnt vmcnt(0)" ::: "memory");
    }
  }
  __syncthreads();
}

__device__ void run_phase(const Params& p, int ph, char* smem) {
  if (ph == 0) { if (PHMASK & (1u << 13)) setup_phase(p, smem); return; }
  if (ph == NPH - 1) { if (PHMASK & (1u << 14)) final_phase(p); return; }
  const int q = ph - 1;
  const int pair = q / 19, rem = q - pair * 19;
  const bool even = rem < 10;
  const int layer = pair * 2 + (even ? 0 : 1);
  int st = even ? rem : rem - 10;
  const bool last = (layer == 3);
  const int li = layer >> 1;
  if (!even && st >= 3) st += 1;
  GemmDesc g, g2;
  g.layer = layer; g.gate_off = 0; g.skip_ctx = 0; g.A = nullptr; g.W = nullptr; g.lda = 1024; g.K = 1024; g.ntn = 0; g.epi = 0;
  g2 = g;
  int ntn2 = 0;
  bool is_gemm = false;
  switch (st) {
    case 0: if (PHMASK & 1u) norm_phase(p, layer, 0, false); break;
    case 1:
      is_gemm = true;
      g.A = (const bf16_t*)((char*)p.out);
      if (even) { g.W = (const bf16_t*)(p.ws + OFF_EVIN + li * SZ_EVIN); g.ntn = 9; g.epi = EPI_U_EVEN; }
      else { g.W = (const bf16_t*)(p.ws + OFF_ODIN + li * SZ_ODIN); g.ntn = 13; g.epi = EPI_U_ODD; }
      break;
    case 2: if (PHMASK & 4u) conv_phase(p, layer, even, smem); break;
    case 3:
      is_gemm = true;
      g.lda = 2304; g.K = 256; g.A = (const bf16_t*)(p.ws + OFF_UE); g.W = (const bf16_t*)(p.ws + OFF_UQ + li * SZ_UQ); g.epi = EPI_Q; g.ntn = 3;
      g2 = g; g2.A = (const bf16_t*)(p.ws + OFF_UE) + 256; g2.W = (const bf16_t*)(p.ws + OFF_UKV + li * SZ_UKV); g2.epi = EPI_KV; ntn2 = 4;
      break;
    case 4:
      if (even) {
        const int G_ = gridDim.x, bi = bidx();
        const bool bal = (G_ == 256);
        const int nit = bal ? (bi < 64 ? 2 : (bi < 128 ? 1 : 4)) : ((704 - bi + G_ - 1) / G_);
        for (int it = 0; it < nit; ++it) {
          int kind, ta, tb, tc;
          if (bal) {
            if (bi < 128) { if (it == 0) { kind = 0; ta = bi >> 4; tb = (bi >> 3) & 1; tc = bi & 7; } else { kind = 1; ta = bi >> 3; tb = bi & 7; tc = 8; } }
            else { const int j = bi - 128, xcd = j & 7, slot = j >> 3; const int bh = it * 16 + 2 * xcd + (slot >> 3); kind = 1; ta = bh >> 3; tb = bh & 7; tc = slot & 7; }
          } else {
            const int t = bi + it * G_;
            if (t < 128) { kind = 0; ta = t >> 4; tb = (t >> 3) & 1; tc = t & 7; }
            else { const int u = t - 128, bh = u / 9; kind = 1; ta = bh >> 3; tb = bh & 7; tc = u % 9; }
          }
          if (kind == 0) { if (PHMASK & (1u << 11)) ssd_tile(p, li, ta, tb, tc, smem); }
          else { if (PHMASK & (1u << 12)) attn_tile(p, ta, tb, tc, smem); }
        }
      } else {
        if (PHMASK & (1u << 10)) for (int t = bidx(); t < 256; t += gridDim.x) { int b = t >> 5, d = (t >> 4) & 1, hh = (t >> 1) & 7, vh = t & 1; mlstm_tile(p, li, b, d, hh, vh, smem); }
      }
      break;
    case 5: if (PHMASK & 32u) { if (even) gnorm_phase(p, layer); else finish_phase(p, layer); } break;
    case 6:
      is_gemm = true;
      g.A = (const bf16_t*)((char*)p.out); g.ntn = 4; g.epi = EPI_RESID; g.gate_off = 2048; g.skip_ctx = last;
      g.W = (const bf16_t*)(p.ws + (even ? OFF_EVOUT : OFF_ODOUT) + li * SZ_OUT);
      break;
    case 7: if (PHMASK & 1u) norm_phase(p, layer, 1, last); break;
    case 8:
      is_gemm = true;
      g.A = (const bf16_t*)((char*)p.out); g.ntn = 16; g.epi = EPI_SQRELU; g.skip_ctx = last;
      g.W = (const bf16_t*)(p.ws + OFF_W1 + layer * SZ_W1);
      break;
    case 9:
      is_gemm = true;
      g.A = (const bf16_t*)(p.ws + OFF_S); g.lda = 4096; g.K = 4096; g.ntn = 4; g.epi = EPI_RESID; g.gate_off = 5120; g.skip_ctx = last;
      g.W = (const bf16_t*)(p.ws + OFF_W2 + layer * SZ_W2);
      break;
  }
  if ((PHMASK & 2u) && is_gemm) {
    const int ntn = g.ntn + ntn2;
    const int nrt = (g.epi == EPI_RESID) ? 9 : (((g.epi == EPI_SQRELU && !g.skip_ctx) || g.epi == EPI_U_ODD) ? 12 : 16);
    const int per_b = LB / (nrt * 16);
    const int Tm = R / (nrt * 16);
    const int total = Tm * ntn;
    const int nig = 8 * ntn;
    const int nxb = gridDim.x >> 3;
    const int bi = bidx();
    const int spos = (bi & 7) * nxb + (bi >> 3);
    auto advance = [&](int& t0_, int& mt_, int& nt_) -> bool {
      while (true) {
        const int sidx = t0_ + spos;
        t0_ += gridDim.x;
        if (sidx >= total) return false;
        const int gid = sidx / nig, rem = sidx - gid * nig;
        const int fm = gid * 8;
        const int gsz = (Tm - fm) < 8 ? (Tm - fm) : 8;
        mt_ = fm + rem % gsz; nt_ = rem / gsz;
        if (g.skip_ctx && (mt_ % per_b) == per_b - 1) continue;
        return true;
      }
    };
    int t0 = 0, mt = 0, nt = 0;
    bool have = advance(t0, mt, nt);
    bool first = true;
    while (have) {
      int t0n = t0, mtn = 0, ntn_ = 0;
      const bool hn = advance(t0n, mtn, ntn_);
      GemmDesc h = g;
      int ntl = nt;
      if (nt >= g.ntn) { h.A = g2.A; h.W = g2.W; h.epi = g2.epi; ntl = nt - g.ntn; }
      const bf16_t* An = (ntn_ >= g.ntn) ? g2.A : g.A;
      const bf16_t* Wn = (ntn_ >= g.ntn) ? g2.W : g.W;
      const int ntnl = (ntn_ >= g.ntn) ? ntn_ - g.ntn : ntn_;
      An += (size_t)(mtn * nrt * 16) * g.lda;
      Wn += (size_t)(ntnl * 256) * g.K;
      gemm_tile(p, h, mt, ntl, smem, nrt, An, Wn, hn, first);
      first = false; have = hn; t0 = t0n; mt = mtn; nt = ntn_;
    }
  }
}

__global__ void __launch_bounds__(NT) mega(Params p) {
  extern __shared__ __attribute__((aligned(1024))) char smem[];
  volatile LAS unsigned* st = (volatile LAS unsigned*)(smem + LDS_PHASE);
  if (threadIdx.x == 0) { st[0] = 0u; st[1] = 0u; }
  __syncthreads();
  XcdBarrier xb = xcd_barrier_post((unsigned*)(p.ws + OFF_BAR), st);
  for (int ph = p.ph_begin; ph < p.ph_end; ++ph) {
    run_phase(p, ph, smem);
    if (p.coop && ph + 1 < p.ph_end) {
      if (ph == 0) cg::this_grid().sync();
      else xcd_barrier(xb);
    }
  }
}

__global__ void __launch_bounds__(256) dump_bf16(const bf16_t* src, float* dst, size_t n) {
  for (size_t i = (size_t)blockIdx.x * 256 + threadIdx.x; i < n; i += (size_t)gridDim.x * 256) dst[i] = __uint_as_float(((unsigned)src[i]) << 16);
}
__global__ void __launch_bounds__(256) dump_f32(const float* src, float* dst, size_t n) {
  for (size_t i = (size_t)blockIdx.x * 256 + threadIdx.x; i < n; i += (size_t)gridDim.x * 256) dst[i] = src[i];
}

extern "C" void kernel_launch(void* const* d_in, const int* in_sizes, int n_in, void* d_out, int out_size, void* d_ws, size_t ws_size, hipStream_t stream) {
  (void)in_sizes; (void)n_in; (void)out_size;
  if (ws_size < WS_TOTAL) { fprintf(stderr, "workspace too small: %zu < %zu\n", ws_size, (size_t)WS_NEED); return; }
  Params p;
  memset(&p, 0, sizeof(p));
  const float** fp = (const float**)&p.x;
  for (int i = 0; i < 30; ++i) fp[i] = (const float*)d_in[i];
  p.out = (float*)d_out; p.ws = (char*)d_ws;
#ifdef DBG_MEMSET
  (void)hipMemsetAsync((char*)d_ws + DBG_MS_OFF, 0, DBG_MS_LEN, stream);
#endif
  static bool attr_set = false;
  if (!attr_set) { (void)hipFuncSetAttribute((const void*)mega, hipFuncAttributeMaxDynamicSharedMemorySize, LDS_BYTES); attr_set = true; }
#if SINGLE_LAUNCH
  static int grid_blocks = 0;
  if (!grid_blocks) {
    int dev = 0, cus = 0, per_cu = 0;
    hipGetDevice(&dev);
    hipDeviceGetAttribute(&cus, hipDeviceAttributeMultiprocessorCount, dev);
    hipOccupancyMaxActiveBlocksPerMultiprocessor(&per_cu, mega, NT, LDS_BYTES);
    if (per_cu > 1) per_cu = 1;
    grid_blocks = cus * per_cu;
  }
  (void)hipMemsetAsync((char*)d_ws + OFF_BAR, 0, 16384, stream);
  p.ph_begin = 0; p.ph_end = NPH; p.coop = 1;
  void* args[] = {&p};
  hipError_t e = hipLaunchCooperativeKernel((void*)mega, dim3(grid_blocks), dim3(NT), args, LDS_BYTES, stream);
  if (e != hipSuccess) fprintf(stderr, "cooperative launch failed: %s (grid %d)\n", hipGetErrorString(e), grid_blocks);
#else
  for (int ph = 0; ph < NPH; ++ph) {
    if (ph >= 1 && ph < NPH - 1) { int q_ = ph - 1; int pr_ = q_ / 19, rm_ = q_ % 19; int ly_ = pr_ * 2 + (rm_ < 10 ? 0 : 1); if (!((DBG_LAYERS >> ly_) & 1)) continue; }
#ifdef DBG_STOP_PH
    if (ph > DBG_STOP_PH) continue;
#endif
    p.ph_begin = ph; p.ph_end = ph + 1; p.coop = 0;
    hipLaunchKernelGGL(mega, dim3(256), dim3(NT), LDS_BYTES, stream, p);
  }
#ifdef DBG_STOP_PH
#if DBG_DUMP_F32
  hipLaunchKernelGGL(dump_f32, dim3(2048), dim3(256), 0, stream, (const float*)((char*)d_ws + DBG_DUMP_OFF), (float*)d_out, (size_t)DBG_DUMP_N);
#else
  hipLaunchKernelGGL(dump_bf16, dim3(2048), dim3(256), 0, stream, (const bf16_t*)((char*)d_ws + DBG_DUMP_OFF), (float*)d_out, (size_t)DBG_DUMP_N);
#endif
#endif
#endif
}
```
